# Optimizing an MI355X kernel written in HIP

```python
import jax, jax.numpy as jnp
from jax import lax
import numpy as np

D_MODEL = 1024
BATCH = 4
SEQ = 4096
DEPTH = 1

MOBA_HEADS = 8
MOBA_HEAD_DIM = 64
MOBA_WIDTH = MOBA_HEADS * MOBA_HEAD_DIM
MOBA_BLOCK = 256
MOBA_TOPK = 3
MOBA_ROW_BLOCK = 128
ROPE_THETA = 10000.0
RET_HEADS = 4
RET_QK_DIM = 128
RET_V_DIM = 256
RET_QK_WIDTH = RET_HEADS * RET_QK_DIM
RET_V_WIDTH = RET_HEADS * RET_V_DIM
RET_CHUNK = 256
RET_ANGLE_BASE = 10000.0
SEQ_PAD = 256
N_IN = 3 * MOBA_WIDTH + 2 * RET_QK_WIDTH + 2 * RET_V_WIDTH + 2 * D_MODEL
N_EXPERTS = 64
TOP_K = 6
N_GROUPS = 8
TOPK_GROUPS = 4
D_EXPERT = 256
D_SHARED = 256
ROUTED_SCALE = 2.5
MOE_ROW_BLOCK = 128
PLE_DIM = 256
LN_EPS = 1e-5
GN_EPS = 1e-6

kernel_name = 'moba_retention_moe_deepnorm_hybrid'

f32 = jnp.float32


def _layer_norm(x, g, b):
    xf = x.astype(f32)
    mu = jnp.mean(xf, -1, keepdims=True)
    var = jnp.mean(jnp.square(xf - mu), -1, keepdims=True)
    return ((xf - mu) * lax.rsqrt(var + LN_EPS) * g.astype(f32) + b.astype(f32)).astype(x.dtype)


def _rotary(x, inv_freq):
    S = x.shape[2]
    ang = jnp.arange(S, dtype=f32)[:, None] * inv_freq[None, :]
    cos = jnp.cos(ang).astype(x.dtype)
    sin = jnp.sin(ang).astype(x.dtype)
    x1, x2 = jnp.split(x, 2, axis=-1)
    return jnp.concatenate([x1 * cos - x2 * sin, x2 * cos + x1 * sin], axis=-1)


def _group_rows(ids, n_groups, row_block):
    n = ids.shape[0]
    order = jnp.argsort(ids)
    sorted_ids = ids[order]
    counts = jax.ops.segment_sum(jnp.ones((n,), jnp.int32), ids, num_segments=n_groups)
    starts = jnp.cumsum(counts) - counts
    padded = (counts + row_block - 1) // row_block * row_block
    pends = jnp.cumsum(padded)
    pstarts = pends - padded
    rank = jnp.arange(n, dtype=jnp.int32) - starts[sorted_ids]
    slot = jnp.zeros((n,), jnp.int32).at[order].set(pstarts[sorted_ids] + rank)
    n_rows = -(-(n + n_groups * (row_block - 1)) // row_block) * row_block
    block_start = jnp.arange(n_rows // row_block, dtype=jnp.int32) * row_block
    block_gid = jnp.minimum(jnp.searchsorted(pends, block_start, side='right'), n_groups - 1).astype(jnp.int32)
    row_item = jnp.full((n_rows,), n, jnp.int32).at[slot].set(jnp.arange(n, dtype=jnp.int32))
    return slot, row_item, block_gid


def _moba(q, k, v):
    B, H, S, Dh = q.shape
    nB = S // MOBA_BLOCK
    pos = jnp.arange(S, dtype=jnp.int32)
    q_blk = pos // MOBA_BLOCK
    kb = k.reshape(B * H * nB, MOBA_BLOCK, Dh)
    vb = v.reshape(B * H * nB, MOBA_BLOCK, Dh)
    k_mean = jnp.mean(kb.astype(f32), axis=1).reshape(B, H, nB, Dh)
    gate = jnp.einsum('bhsd,bhnd->bhsn', q.astype(f32), k_mean)
    past = jnp.arange(nB, dtype=jnp.int32)[None, :] < q_blk[:, None]
    gate = jnp.where(past, gate, -jnp.inf)
    _, top = lax.top_k(gate, min(MOBA_TOPK, nB))
    own = jnp.broadcast_to(q_blk[:, None], (B, H, S, 1))
    sel = jnp.concatenate([top, own], axis=-1)
    valid = jnp.concatenate([top < q_blk[:, None], jnp.ones((B, H, S, 1), bool)], axis=-1)
    J = sel.shape[-1]
    bh = jnp.arange(B * H, dtype=jnp.int32).reshape(B, H, 1, 1)
    gid = (bh * nB + sel).reshape(-1)
    slot, row_item, block_gid = _group_rows(gid, B * H * nB, MOBA_ROW_BLOCK)
    item_q = jnp.broadcast_to(bh * S + pos[None, None, :, None], (B, H, S, J)).reshape(-1)
    item_pos = jnp.broadcast_to(pos[None, None, :, None], (B, H, S, J)).reshape(-1)
    row_q = jnp.concatenate([item_q, jnp.zeros((1,), jnp.int32)])[row_item]
    row_pos = jnp.concatenate([item_pos, jnp.full((1,), -1, jnp.int32)])[row_item]
    row_valid = jnp.concatenate([valid.reshape(-1), jnp.zeros((1,), bool)])[row_item]
    R = MOBA_ROW_BLOCK
    nR = row_item.shape[0] // R
    q_rows = q.reshape(B * H * S, Dh)[row_q].reshape(nR, R, Dh).astype(f32)
    k_rows = kb[block_gid].astype(f32)
    v_rows = vb[block_gid].astype(f32)
    key_pos = (block_gid % nB)[:, None] * MOBA_BLOCK + jnp.arange(MOBA_BLOCK, dtype=jnp.int32)[None, :]
    mask = row_valid.reshape(nR, R, 1) & (key_pos[:, None, :] <= row_pos.reshape(nR, R, 1))
    s = jnp.einsum('nrd,nkd->nrk', q_rows, k_rows) * (Dh ** -0.5)
    s = jnp.where(mask, s, -jnp.inf)
    m = jnp.max(s, axis=-1, keepdims=True)
    m = jnp.where(jnp.isfinite(m), m, 0.0)
    e = jnp.exp(s - m)
    l = jnp.sum(e, axis=-1)
    l_safe = jnp.maximum(l, 1e-30)
    o = jnp.einsum('nrk,nkd->nrd', e, v_rows) / l_safe[..., None]
    lse = jnp.where(l > 0, m[..., 0] + jnp.log(l_safe), -jnp.inf)
    o_item = o.reshape(-1, Dh)[slot].reshape(B, H, S, J, Dh)
    lse_item = lse.reshape(-1)[slot].reshape(B, H, S, J)
    w = jax.nn.softmax(lse_item, axis=-1)
    out = jnp.einsum('bhsj,bhsjd->bhsd', w, o_item)
    return out.astype(q.dtype)


def _retention(q, k, v, gammas):
    B, H, S, dk = q.shape
    dv = v.shape[-1]
    C = RET_CHUNK
    nC = S // C
    qc = q.astype(f32).reshape(B, H, nC, C, dk)
    kc = k.astype(f32).reshape(B, H, nC, C, dk) * (dk ** -0.5)
    vc = v.astype(f32).reshape(B, H, nC, C, dv)
    log_g = jnp.log(gammas)
    idx = jnp.arange(C, dtype=f32)
    diff = idx[:, None] - idx[None, :]
    decay = jnp.where(diff >= 0, jnp.exp(jnp.maximum(diff, 0.0)[None] * log_g[:, None, None]), 0.0)
    scores = jnp.einsum('bhcnd,bhcmd->bhcnm', qc, kc) * decay[None, :, None]
    inner = jnp.einsum('bhcnm,bhcme->bhcne', scores, vc)
    zeta = jnp.exp((C - 1 - idx)[None, :] * log_g[:, None])
    kv = jnp.einsum('bhcmd,bhcme->cbhde', kc * zeta[None, :, None, :, None], vc)
    chunk_decay = jnp.exp(C * log_g)[None, :, None, None]

    def step(state, kv_c):
        return chunk_decay * state + kv_c, state

    _, prev = lax.scan(step, jnp.zeros((B, H, dk, dv), f32), kv)
    xi = jnp.exp((idx + 1.0)[None, :] * log_g[:, None])
    cross = jnp.einsum('bhcnd,cbhde->bhcne', qc, prev) * xi[None, :, None, :, None]
    return (inner + cross).reshape(B, H, S, dv)


def _mixer(x, w_in, w_moba_up, w_ret_up, w_out):
    B, S, D = x.shape
    Sp = -(-S // SEQ_PAD) * SEQ_PAD
    xp = jnp.pad(x, ((0, 0), (0, Sp - S), (0, 0)))
    proj = xp @ w_in
    splits = [MOBA_WIDTH, 2 * MOBA_WIDTH, 3 * MOBA_WIDTH,
              3 * MOBA_WIDTH + RET_QK_WIDTH, 3 * MOBA_WIDTH + 2 * RET_QK_WIDTH,
              3 * MOBA_WIDTH + 2 * RET_QK_WIDTH + RET_V_WIDTH,
              3 * MOBA_WIDTH + 2 * RET_QK_WIDTH + 2 * RET_V_WIDTH,
              3 * MOBA_WIDTH + 2 * RET_QK_WIDTH + 2 * RET_V_WIDTH + D_MODEL]
    qa, ka, va, qr, kr, vr, gr, ga, gb = jnp.split(proj, splits, axis=-1)

    def heads(t, n):
        return t.reshape(B, Sp, n, -1).transpose(0, 2, 1, 3)

    inv_a = 1.0 / (ROPE_THETA ** (jnp.arange(0, MOBA_HEAD_DIM, 2, dtype=f32) / MOBA_HEAD_DIM))
    oa = _moba(_rotary(heads(qa, MOBA_HEADS), inv_a), _rotary(heads(ka, MOBA_HEADS), inv_a), heads(va, MOBA_HEADS))
    oa = oa.transpose(0, 2, 1, 3).reshape(B, Sp, MOBA_WIDTH)
    inv_r = 1.0 / (RET_ANGLE_BASE ** jnp.linspace(0.0, 1.0, RET_QK_DIM // 2, dtype=f32))
    gammas = 1.0 - 2.0 ** (-5.0 - jnp.arange(RET_HEADS, dtype=f32))
    orr = _retention(_rotary(heads(qr, RET_HEADS), inv_r), _rotary(heads(kr, RET_HEADS), inv_r), heads(vr, RET_HEADS), gammas)
    mu = jnp.mean(orr, -1, keepdims=True)
    var = jnp.mean(jnp.square(orr - mu), -1, keepdims=True)
    orr = (orr - mu) * lax.rsqrt(var + GN_EPS)
    orr = orr.transpose(0, 2, 1, 3).reshape(B, Sp, RET_V_WIDTH).astype(x.dtype) * jax.nn.silu(gr)
    merged = jax.nn.sigmoid(ga) * (oa @ w_moba_up) + jax.nn.sigmoid(gb) * (orr @ w_ret_up)
    return (merged @ w_out)[:, :S]


def _moe(h, w_router, router_bias, w_eg, w_eu, w_ed, w_sg, w_su, w_sd):
    B, S, D = h.shape
    T = B * S
    x = h.reshape(T, D)
    scores = jax.nn.sigmoid(x.astype(f32) @ w_router.astype(f32))
    biased = scores + router_bias.astype(f32)[None, :]
    per_group = N_EXPERTS // N_GROUPS
    g_score = jnp.sum(lax.top_k(biased.reshape(T, N_GROUPS, per_group), 2)[0], axis=-1)
    _, top_g = lax.top_k(g_score, TOPK_GROUPS)
    g_mask = jnp.sum(jax.nn.one_hot(top_g, N_GROUPS, dtype=f32), axis=1) > 0
    e_mask = jnp.repeat(g_mask, per_group, axis=1)
    _, top_e = lax.top_k(jnp.where(e_mask, biased, -jnp.inf), TOP_K)
    w = jnp.take_along_axis(scores, top_e, axis=1)
    w = w / jnp.sum(w, -1, keepdims=True) * ROUTED_SCALE
    slot, row_item, block_eid = _group_rows(top_e.reshape(-1), N_EXPERTS, MOE_ROW_BLOCK)
    row_tok = row_item // TOP_K
    x_pad = jnp.concatenate([x, jnp.zeros((1, D), x.dtype)], axis=0)
    x_rows = x_pad[row_tok].reshape(-1, MOE_ROW_BLOCK, D)

    def expert_block(args):
        xb, e = args
        return (jax.nn.silu(xb @ w_eg[e]) * (xb @ w_eu[e])) @ w_ed[e]

    y_rows = lax.map(expert_block, (x_rows, block_eid)).reshape(-1, D)
    y_sel = y_rows[slot].reshape(T, TOP_K, D)
    routed = jnp.einsum('tk,tkd->td', w.astype(x.dtype), y_sel)
    shared = (jax.nn.silu(x @ w_sg) * (x @ w_su)) @ w_sd
    return (routed + shared).reshape(B, S, D)


def setup_inputs(seed: int = 0) -> dict:
    key = jax.random.key(seed)
    ks = jax.random.split(key, 22)
    L = DEPTH
    beta = (8.0 * DEPTH) ** -0.25

    def nrm(k, shape, fan_in, scale=1.0):
        return jax.random.normal(k, shape, f32) * (scale * fan_in ** -0.5)

    def gain(k, shape):
        return 1.0 + 0.02 * jax.random.normal(k, shape, f32)

    def bias(k, shape, s=0.02):
        return s * jax.random.normal(k, shape, f32)

    col_scale = jnp.concatenate([
        jnp.ones((2 * MOBA_WIDTH,), f32), jnp.full((MOBA_WIDTH,), beta, f32),
        jnp.ones((2 * RET_QK_WIDTH,), f32), jnp.full((RET_V_WIDTH,), beta, f32),
        jnp.ones((RET_V_WIDTH + 2 * D_MODEL,), f32)])
    return {
        'x': jax.random.normal(ks[0], (BATCH, SEQ, D_MODEL), f32),
        'p': jax.random.normal(ks[1], (DEPTH, BATCH, SEQ, PLE_DIM), f32),
        'w_in': nrm(ks[2], (L, D_MODEL, N_IN), D_MODEL) * col_scale,
        'w_moba_up': nrm(ks[3], (L, MOBA_WIDTH, D_MODEL), MOBA_WIDTH),
        'w_ret_up': nrm(ks[4], (L, RET_V_WIDTH, D_MODEL), RET_V_WIDTH),
        'w_out': nrm(ks[5], (L, D_MODEL, D_MODEL), D_MODEL, beta),
        'ln1_g': gain(ks[6], (L, D_MODEL)),
        'ln1_b': bias(ks[7], (L, D_MODEL)),
        'w_router': nrm(ks[8], (L, D_MODEL, N_EXPERTS), D_MODEL),
        'router_bias': bias(ks[9], (L, N_EXPERTS), 0.01),
        'w_exp_gate': nrm(ks[10], (L, N_EXPERTS, D_MODEL, D_EXPERT), D_MODEL),
        'w_exp_up': nrm(ks[11], (L, N_EXPERTS, D_MODEL, D_EXPERT), D_MODEL),
        'w_exp_down': nrm(ks[12], (L, N_EXPERTS, D_EXPERT, D_MODEL), D_EXPERT, beta),
        'w_sh_gate': nrm(ks[13], (L, D_MODEL, D_SHARED), D_MODEL),
        'w_sh_up': nrm(ks[14], (L, D_MODEL, D_SHARED), D_MODEL),
        'w_sh_down': nrm(ks[15], (L, D_SHARED, D_MODEL), D_SHARED, beta),
        'ln2_g': gain(ks[16], (L, D_MODEL)),
        'ln2_b': bias(ks[17], (L, D_MODEL)),
        'w_ple_proj': nrm(ks[18], (L, PLE_DIM, D_MODEL), PLE_DIM, beta),
        'w_ple_gate': nrm(ks[19], (L, D_MODEL, D_MODEL), D_MODEL),
        'ln3_g': gain(ks[20], (L, D_MODEL)),
        'ln3_b': bias(ks[21], (L, D_MODEL)),
    }


def reference(x, p, w_in, w_moba_up, w_ret_up, w_out, ln1_g, ln1_b, w_router, router_bias,
              w_exp_gate, w_exp_up, w_exp_down, w_sh_gate, w_sh_up, w_sh_down, ln2_g, ln2_b,
              w_ple_proj, w_ple_gate, ln3_g, ln3_b):
    alpha = (2.0 * DEPTH) ** 0.25
    h = x
    for i in range(DEPTH):
        h = _layer_norm(alpha * h + _mixer(h, w_in[i], w_moba_up[i], w_ret_up[i], w_out[i]), ln1_g[i], ln1_b[i])
        h = _layer_norm(alpha * h + _moe(h, w_router[i], router_bias[i], w_exp_gate[i], w_exp_up[i], w_exp_down[i],
                                         w_sh_gate[i], w_sh_up[i], w_sh_down[i]), ln2_g[i], ln2_b[i])
        ple = (p[i] @ w_ple_proj[i]) * jax.nn.sigmoid(h @ w_ple_gate[i])
        h = _layer_norm(alpha * h + ple, ln3_g[i], ln3_b[i])
    return h
```

```cpp
#include <hip/hip_runtime.h>
#include <hip/hip_bf16.h>
#include <cstdio>
#include <cstdint>
#include <cmath>

#define LAS __attribute__((address_space(3)))
#define GAS __attribute__((address_space(1)))
typedef unsigned short bf16_t;
typedef short bf16x8 __attribute__((ext_vector_type(8)));
typedef float f32x4 __attribute__((ext_vector_type(4)));
typedef float f32x2 __attribute__((ext_vector_type(2)));
typedef unsigned u32x4 __attribute__((ext_vector_type(4)));
typedef unsigned u32x2 __attribute__((ext_vector_type(2)));
typedef __bf16 bf16x2_t __attribute__((ext_vector_type(2)));

__device__ __forceinline__ unsigned pk2(float lo, float hi) { f32x2 v = {lo, hi}; bf16x2_t b = __builtin_convertvector(v, bf16x2_t); return __builtin_bit_cast(unsigned, b); }
__device__ __forceinline__ unsigned short f2bf(float f) { return (unsigned short)(pk2(f, 0.f) & 0xffffu); }
__device__ __forceinline__ float bf2f(unsigned short h) { return __uint_as_float(((unsigned)h) << 16); }
__device__ __forceinline__ float bflo(unsigned w) { return __uint_as_float(w << 16); }
__device__ __forceinline__ float bfhi(unsigned w) { return __uint_as_float(w & 0xffff0000u); }
__device__ __forceinline__ int lane_id_v() { int l; asm volatile("v_mbcnt_lo_u32_b32 %0, -1, 0\n\tv_mbcnt_hi_u32_b32 %0, -1, %0" : "=v"(l)); return l; }
__device__ __forceinline__ float sigmoidf_(float x) { return __builtin_amdgcn_rcpf(1.0f + __builtin_amdgcn_exp2f(-1.4426950408889634f * x)); }

namespace pg8 {
constexpr int BM = 256, BK = 64, HALF = 128, HTB = HALF * BK * 2  , STAGE_BYTES = 8 * HTB;

__host__ __device__ __forceinline__ int lds_byte(int r, int c) { const int st = (r >> 4) * 2 + (c >> 5), rr = r & 15, cc = c & 31, ob = rr * 64 + cc * 2; return st * 1024 + (ob ^ (((ob >> 9) & 1) << 5)); }
__host__ __device__ __forceinline__ void stage_rc(int b, int& R, int& C) { const int st = b / 1024, sb = b % 1024, swz = sb ^ (((sb >> 9) & 1) << 5); R = (st >> 1) * 16 + swz / 64; C = (st & 1) * 32 + (swz % 64) / 2; }

struct Unit { const char* A; const char* B; int i0, i1, i2, i3; };

template <class Epi, class Sched, bool GATHER>
__device__ __forceinline__ void gemm_phase(const int wid, LAS unsigned char* lds, LAS unsigned char* lds_epi, const int lda, const int ldb, const int K, const Sched& S, const Epi& E) {
    const int lane = lane_id_v(), tid = wid * 64 + lane, wr = wid >> 2, wc = wid & 3, fr = lane & 15, fq = lane >> 4;
    int nt = K / BK; asm volatile("" : "+s"(nt));
    int R_[2], C_[2];
#pragma unroll
    for (int i = 0; i < 2; ++i) stage_rc(tid * 16 + i * 8192, R_[i], C_[i]);
    unsigned voB[2];
#pragma unroll
    for (int i = 0; i < 2; ++i) voB[i] = (unsigned)(R_[i] * ldb + C_[i]) * 2u;
    unsigned voA[2][2], nvoA[2][2];
    unsigned voD[2];
#pragma unroll
    for (int i = 0; i < 2; ++i) voD[i] = (unsigned)(R_[i] * lda + C_[i]) * 2u;
    const size_t hstepA = (size_t)HALF * lda * 2;
    const size_t kstep = (size_t)(BK * 2);
    const size_t hstepB = (size_t)HALF * ldb * 2;
    const unsigned ldsw = (unsigned)wid * 1024u;
    const int aoff = lds_byte(wr * 64 + fr, fq * 8), boff = lds_byte(wc * 32 + fr, fq * 8);
#define PG8_SA(b, h) (((b) * 2 + (h)) * HTB)
#define PG8_SB(b, h) ((4 + (b) * 2 + (h)) * HTB)
#define PG8_STAGE2(bufoff, gbase, o0, o1) do { \
        __builtin_amdgcn_global_load_lds((const unsigned*)((const char*)(gbase) + (o0)), (LAS unsigned*)(lds + (bufoff) + ldsw), 16, 0, 0); \
        __builtin_amdgcn_global_load_lds((const unsigned*)((const char*)(gbase) + (o1)), (LAS unsigned*)(lds + (bufoff) + ldsw + 8192), 16, 0, 0); } while (0)
#define PG8_STAGEB(bufoff, gbase) PG8_STAGE2(bufoff, gbase, voB[0], voB[1])
#define PG8_LDA(dst, b, h) do { _Pragma("unroll") for (int m = 0; m < 4; ++m) _Pragma("unroll") for (int k = 0; k < 2; ++k) dst[m][k] = *(const LAS bf16x8*)(lds + PG8_SA(b, h) + aoff + m * 2048 + k * 1024); } while (0)
#define PG8_LDB(dst, b, h) do { _Pragma("unroll") for (int n = 0; n < 2; ++n) _Pragma("unroll") for (int k = 0; k < 2; ++k) dst[n][k] = *(const LAS bf16x8*)(lds + PG8_SB(b, h) + boff + n * 2048 + k * 1024); } while (0)
#define PG8_MMA(ai, bj, At, Bt) do { __builtin_amdgcn_s_setprio(1); _Pragma("unroll") for (int m = 0; m < 4; ++m) _Pragma("unroll") for (int n = 0; n < 2; ++n) _Pragma("unroll") for (int k = 0; k < 2; ++k) \
        acc[ai][bj][m][n] = __builtin_amdgcn_mfma_f32_16x16x32_bf16(Bt[n][k], At[m][k], acc[ai][bj][m][n], 0, 0, 0); __builtin_amdgcn_s_setprio(0); } while (0)
#define PG8_WAIT_V(n) asm volatile("s_waitcnt vmcnt(" #n ")" ::: "memory")
#define PG8_WAIT_L(n) asm volatile("s_waitcnt lgkmcnt(" #n ")" ::: "memory")
#define PG8_BAR __builtin_amdgcn_s_barrier()
#define PG8_SCHED __builtin_amdgcn_sched_barrier(0)
#define PG8_OFFS(dst, u) do { _Pragma("unroll") for (int h_ = 0; h_ < 2; ++h_) _Pragma("unroll") for (int i_ = 0; i_ < 2; ++i_) dst[h_][i_] = S.row_off(u, R_[i_] + HALF * h_) + (unsigned)C_[i_] * 2u; } while (0)
#define PG8_STAGEA(bufoff, gbase, h, NX) do { if constexpr (GATHER) { PG8_STAGE2(bufoff, gbase, ((NX) ? nvoA[h][0] : voA[h][0]), ((NX) ? nvoA[h][1] : voA[h][1])); } \
        else { PG8_STAGE2(bufoff, (gbase) + (h) * hstepA, voD[0], voD[1]); } } while (0)
    Unit cur, nxt; int ui = 0;
    if (!S.next(0, cur)) return;
    f32x4 acc[2][2][4][2];
#pragma unroll
    for (int a = 0; a < 2; ++a)
#pragma unroll
        for (int b = 0; b < 2; ++b)
#pragma unroll
            for (int m = 0; m < 4; ++m)
#pragma unroll
                for (int n = 0; n < 2; ++n) acc[a][b][m][n] = (f32x4){0.f, 0.f, 0.f, 0.f};
    bf16x8 At[4][2], B0[2][2], B1[2][2];
    const char* cA = cur.A; const char* cB = cur.B;
    if constexpr (GATHER) { PG8_OFFS(voA, cur); }
    PG8_STAGEB(PG8_SB(0, 0), cB); PG8_STAGEB(PG8_SB(0, 1), cB + hstepB); PG8_STAGEA(PG8_SA(0, 0), cA, 0, false); PG8_STAGEA(PG8_SA(0, 1), cA, 1, false);
    if (wr == 1) PG8_BAR;
    PG8_WAIT_V(2); PG8_BAR;
    PG8_STAGEB(PG8_SB(1, 0), cB + kstep); PG8_STAGEA(PG8_SA(1, 0), cA + kstep, 0, false); PG8_STAGEB(PG8_SB(1, 1), cB + hstepB + kstep);
    PG8_WAIT_V(6); PG8_BAR;
    for (;;) {
        const bool has_next = S.next(ui + 1, nxt);
        const char* nA = has_next ? nxt.A : cA; const char* nB = has_next ? nxt.B : cB;
        if constexpr (GATHER) { if (has_next) { PG8_OFFS(nvoA, nxt); } else {
#pragma unroll
            for (int h_ = 0; h_ < 2; ++h_)
#pragma unroll
                for (int i_ = 0; i_ < 2; ++i_) nvoA[h_][i_] = voA[h_][i_]; } }
        for (int t = 0; t < nt; t += 2) {
            const bool last = (t == nt - 2);
            const char* a1 = cA + (size_t)(t + 1) * kstep;
            const char* a2 = last ? nA : cA + (size_t)(t + 2) * kstep; const char* b2 = last ? nB : cB + (size_t)(t + 2) * kstep;
            const char* a3 = a2 + kstep; const char* b3 = b2 + kstep;
            PG8_LDB(B0, 0, 0); PG8_LDB(B1, 0, 1); PG8_SCHED; PG8_LDA(At, 0, 0); PG8_STAGEA(PG8_SA(1, 1), a1, 1, false);
            PG8_WAIT_V(8); PG8_WAIT_L(0); PG8_BAR; PG8_MMA(0, 0, At, B0); PG8_MMA(0, 1, At, B1); PG8_BAR; PG8_SCHED;
            PG8_LDA(At, 0, 1); PG8_STAGEB(PG8_SB(0, 0), b2); PG8_STAGEB(PG8_SB(0, 1), b2 + hstepB); PG8_STAGEA(PG8_SA(0, 0), a2, 0, last);
            PG8_WAIT_V(8); PG8_WAIT_L(0); PG8_BAR; PG8_MMA(1, 0, At, B0); PG8_MMA(1, 1, At, B1); PG8_BAR; PG8_SCHED;
            PG8_LDB(B0, 1, 0); PG8_LDB(B1, 1, 1); PG8_SCHED; PG8_LDA(At, 1, 0); PG8_STAGEA(PG8_SA(0, 1), a2, 1, last);
            PG8_WAIT_V(8); PG8_WAIT_L(0); PG8_BAR; PG8_MMA(0, 0, At, B0); PG8_MMA(0, 1, At, B1); PG8_BAR; PG8_SCHED;
            PG8_LDA(At, 1, 1); PG8_STAGEB(PG8_SB(1, 0), b3); PG8_STAGEB(PG8_SB(1, 1), b3 + hstepB); PG8_STAGEA(PG8_SA(1, 0), a3, 0, last);
            PG8_WAIT_V(8); PG8_WAIT_L(0); PG8_BAR; PG8_MMA(1, 0, At, B0); PG8_MMA(1, 1, At, B1); PG8_BAR; PG8_SCHED;
        }
        if (wr == 0) PG8_BAR;
        { int fr_ = fr, fq_ = fq, wr_ = wr, wc_ = wc, lane_ = lane;
          asm volatile("" : "+v"(fr_), "+v"(fq_), "+s"(wr_), "+s"(wc_), "+v"(lane_));
          E(acc, cur, wr_, wc_, fr_, fq_, lds_epi, wid, lane_); }
        if (!has_next) break;
#pragma unroll
        for (int a = 0; a < 2; ++a)
#pragma unroll
            for (int b = 0; b < 2; ++b)
#pragma unroll
                for (int m = 0; m < 4; ++m)
#pragma unroll
                    for (int n = 0; n < 2; ++n) acc[a][b][m][n] = (f32x4){0.f, 0.f, 0.f, 0.f};
        cur = nxt; cA = nA; cB = nB; ++ui;
        if constexpr (GATHER) {
#pragma unroll
            for (int h_ = 0; h_ < 2; ++h_)
#pragma unroll
                for (int i_ = 0; i_ < 2; ++i_) voA[h_][i_] = nvoA[h_][i_]; }
        if (wr == 1) PG8_BAR;
    }
    PG8_WAIT_V(0);
    PG8_BAR;
#undef PG8_SA
#undef PG8_SB
#undef PG8_STAGE2
#undef PG8_STAGEB
#undef PG8_STAGEA
#undef PG8_LDA
#undef PG8_LDB
#undef PG8_MMA
#undef PG8_WAIT_V
#undef PG8_WAIT_L
#undef PG8_BAR
#undef PG8_SCHED
#undef PG8_OFFS
}
}


#include <hip/hip_bf16.h>
#include <cmath>
namespace attn_body {
using bf16=__hip_bfloat16;
using bf16x8=__attribute__((ext_vector_type(8)))short;
using s16x4=__attribute__((ext_vector_type(4)))short;
using f32x16=__attribute__((ext_vector_type(16)))float;
using u32x4=__attribute__((ext_vector_type(4)))unsigned;
constexpr int BATCH=4,NHEAD=8,SEQ=4096,D=64,DM=NHEAD*D;
constexpr int NW=8,QBLK=32,QB=QBLK*NW,KVBLK=64,NQB=SEQ/QB;
constexpr int ATTN_PITCH=DM, ATTN_UNIT_ROWS=QB;
__device__ __forceinline__ int crow(int r,int hi){return (r&3)+8*(r>>2)+4*hi;}
#define SBAR() __builtin_amdgcn_sched_barrier(0)
__device__ __forceinline__ void cmask(f32x16&p0,f32x16&p1,int jb,int qrel,int hi){
  const float NEG=-INFINITY; int kb=64*jb+4*hi;
  #pragma unroll
  for(int r=0;r<16;++r){int kv=kb+(r&3)+8*(r>>2); if(kv>qrel)p0[r]=NEG; if(kv+32>qrel)p1[r]=NEG;}
}

constexpr int NSLOT=3, SLOTB=8192;
constexpr int LDS_K=0, LDS_V=NSLOT*SLOTB, LDS_WS=2*NSLOT*SLOTB, LDS_OST=LDS_WS+NW*64*4, LDS_BYTES=LDS_OST+NW*4096;
constexpr float C2=0.125f*1.4426950408889634f;
__device__ __forceinline__ void glds16(const void*gsrc,unsigned lds_dst){unsigned keep;
  asm volatile("s_mov_b32 %0, m0\n\ts_mov_b32 m0, %2\n\ts_nop 0\n\tglobal_load_lds_dwordx4 %1, off\n\ts_mov_b32 m0, %0":"=&s"(keep):"v"(gsrc),"s"(lds_dst):"memory");}
__device__ __forceinline__ float max3f(float a,float b,float c){float r;asm("v_max3_f32 %0, %1, %2, %3":"=v"(r):"v"(a),"v"(b),"v"(c));return r;}
__device__ __forceinline__ float max2f(float a,float b){float r;asm("v_max_f32_e32 %0, %1, %2":"=v"(r):"v"(a),"v"(b));return r;}
__device__ __forceinline__ float fadd_s(float a,float b){float r;asm("v_add_f32_e32 %0, %1, %2":"=v"(r):"v"(a),"v"(b));return r;}
__device__ __forceinline__ float fsub_s(float a,float b){float r;asm("v_sub_f32_e32 %0, %1, %2":"=v"(r):"v"(a),"v"(b));return r;}
typedef float f32x2_t __attribute__((ext_vector_type(2))); typedef __bf16 bf16x2_t __attribute__((ext_vector_type(2)));
__device__ __forceinline__ unsigned cvtpk_s(float lo,float hi){f32x2_t v={lo,hi};bf16x2_t b=__builtin_convertvector(v,bf16x2_t);return __builtin_bit_cast(unsigned,b);}
#define WAIT_BAR(N) asm volatile("s_waitcnt vmcnt(" #N ") lgkmcnt(0)\n\ts_barrier":::"memory")

__device__ __forceinline__ void qkt(f32x16&p0,f32x16&p1,const char*Kslot,const bf16x8*qr,const f32x16&negm,int r32,int hi){
  const char*kb=Kslot+hi*1024+r32*16;
  #pragma unroll
  for(int d0=0;d0<4;++d0){
    const bf16x8 b0=*reinterpret_cast<const bf16x8*>(kb+d0*2048);
    const bf16x8 b1=*reinterpret_cast<const bf16x8*>(kb+d0*2048+512);
    if(d0==0){p0=__builtin_amdgcn_mfma_f32_32x32x16_bf16(b0,qr[0],negm,0,0,0);p1=__builtin_amdgcn_mfma_f32_32x32x16_bf16(b1,qr[0],negm,0,0,0);}
    else{p0=__builtin_amdgcn_mfma_f32_32x32x16_bf16(b0,qr[d0],p0,0,0,0);p1=__builtin_amdgcn_mfma_f32_32x32x16_bf16(b1,qr[d0],p1,0,0,0);}}
}
typedef __attribute__((address_space(3))) const char* lds_cptr;
typedef short v4i16_t __attribute__((ext_vector_type(4)));
__device__ __forceinline__ void kload8(bf16x8*kf,lds_cptr kp){
  kf[0]=*(const __attribute__((address_space(3))) bf16x8*)(kp);      kf[1]=*(const __attribute__((address_space(3))) bf16x8*)(kp+512);
  kf[2]=*(const __attribute__((address_space(3))) bf16x8*)(kp+2048); kf[3]=*(const __attribute__((address_space(3))) bf16x8*)(kp+2560);
  kf[4]=*(const __attribute__((address_space(3))) bf16x8*)(kp+4096); kf[5]=*(const __attribute__((address_space(3))) bf16x8*)(kp+4608);
  kf[6]=*(const __attribute__((address_space(3))) bf16x8*)(kp+6144); kf[7]=*(const __attribute__((address_space(3))) bf16x8*)(kp+6656);
}
__device__ __forceinline__ void kload2(bf16x8*kf,lds_cptr kp,int j){ kf[2*j]=*(const __attribute__((address_space(3))) bf16x8*)(kp+j*2048); kf[2*j+1]=*(const __attribute__((address_space(3))) bf16x8*)(kp+j*2048+512); }
__device__ __forceinline__ s16x4 vtr(lds_cptr p){ return __builtin_bit_cast(s16x4,__builtin_amdgcn_ds_read_tr16_b64_v4i16((__attribute__((address_space(3))) v4i16_t*)p)); }
__device__ __forceinline__ float rowmax(const f32x16&p0,const f32x16&p1){
  float a=max3f(p0[0],p0[1],p1[0]),b=max3f(p0[2],p0[3],p1[1]);a=max3f(a,p1[2],p1[3]);
  #pragma unroll
  for(int r=4;r<16;r+=4){a=max3f(a,p0[r],p0[r+1]);b=max3f(b,p0[r+2],p0[r+3]);a=max3f(a,p1[r],p1[r+1]);b=max3f(b,p1[r+2],p1[r+3]);}
  const float m=max2f(a,b);
  auto rr=__builtin_amdgcn_permlane32_swap(__float_as_uint(m),__float_as_uint(m),false,false);
  return max2f(__uint_as_float(rr[0]),__uint_as_float(rr[1]));
}
__device__ __forceinline__ void pv(f32x16*o,int vb,bf16x8 pa0,bf16x8 pa1,bf16x8 pa2,bf16x8 pa3){
  #pragma unroll
  for(int d0=0;d0<2;++d0){s16x4 lo[4],hi[4];
    #pragma unroll
    for(int ks=0;ks<4;++ks){
      asm volatile("ds_read_b64_tr_b16 %0,%1 offset:%c2":"=&v"(lo[ks]):"v"(vb),"i"(d0*4096+ks*1024):"memory");
      asm volatile("ds_read_b64_tr_b16 %0,%1 offset:%c2":"=&v"(hi[ks]):"v"(vb),"i"(d0*4096+ks*1024+512):"memory");}
    asm volatile("s_waitcnt lgkmcnt(0)":::"memory");SBAR();
    #define PK(k) (bf16x8){lo[k][0],lo[k][1],lo[k][2],lo[k][3],hi[k][0],hi[k][1],hi[k][2],hi[k][3]}
    o[d0]=__builtin_amdgcn_mfma_f32_32x32x16_bf16(pa0,PK(0),o[d0],0,0,0);
    o[d0]=__builtin_amdgcn_mfma_f32_32x32x16_bf16(pa1,PK(1),o[d0],0,0,0);
    o[d0]=__builtin_amdgcn_mfma_f32_32x32x16_bf16(pa2,PK(2),o[d0],0,0,0);
    o[d0]=__builtin_amdgcn_mfma_f32_32x32x16_bf16(pa3,PK(3),o[d0],0,0,0);
    #undef PK
  }
}

#ifndef ATTN_STORE16
#define ATTN_STORE16(p,v) (*(u32x4*)(p)=(v))
#endif
template<int THRL> __device__ __forceinline__ void attn_unit(int b,int h,int qb,const bf16*Q,const bf16*__restrict__ K,const bf16*__restrict__ V,bf16*O,const float*KM,char*shm,const int wid_unused){
  const int tid=threadIdx.x,lane=tid&63,r32=lane&31,hi=lane>>5; const int wid=__builtin_amdgcn_readfirstlane(tid>>6);
  const long rowbase=(long)b*SEQ; const int q0=qb*QB;
  const bf16*Qw=Q+(rowbase+q0+wid*QBLK)*DM+h*D;
  const bf16*Kh=K+rowbase*DM+h*D,*Vh=V+rowbase*DM+h*D;
  const unsigned lds0=(unsigned)(uintptr_t)shm;
  float*wsf=(float*)(shm+LDS_WS)+wid*64;
  const bf16*ksrc=Kh+(long)lane*DM+wid*8;
  const bf16*vsrc=Vh+(long)(16*(wid&3)+(lane>>2))*DM+(wid>>2)*32+(lane&3)*8;
  const unsigned kdst=lds0+LDS_K+wid*1024, vdst=lds0+LDS_V+wid*1024;
  #define DMA_K(t,slot) glds16(ksrc+(long)(t)*KVBLK*DM,(unsigned)__builtin_amdgcn_readfirstlane(kdst+(slot)))
  #define DMA_V(t,slot) glds16(vsrc+(long)(t)*KVBLK*DM,(unsigned)__builtin_amdgcn_readfirstlane(vdst+(slot)))
  const int vb0=(int)(lds0+LDS_V)+((lane>>4)&1)*32+(lane&3)*8+(4*hi+((lane&15)>>2))*64;
  const char*Kbase=shm+LDS_K; bf16x8 kf[8];
  const lds_cptr shm3=(lds_cptr)shm; const lds_cptr kp0=shm3+LDS_K+hi*1024+r32*16; const lds_cptr vp0=shm3+LDS_V+((lane>>4)&1)*32+(lane&3)*8+(4*hi+((lane&15)>>2))*64;
  const int NT=(q0+QB)/KVBLK;
  DMA_K(0,0);DMA_V(0,0);DMA_K(1,SLOTB);
  bf16x8 qr[4];
  #pragma unroll
  for(int d0=0;d0<4;++d0)qr[d0]=*reinterpret_cast<const bf16x8*>(&Qw[(long)r32*DM+d0*16+hi*8]);
  unsigned selmask=0u;
  { const float*km=KM+(long)(b*NHEAD+h)*(SEQ/256)*D;
    if(qb<=3){ selmask=(1u<<qb)-1u; }
    else{
      float qf[32];
      #pragma unroll
      for(int d0=0;d0<4;++d0){
        #pragma unroll
        for(int j=0;j<8;++j)qf[d0*8+j]=__uint_as_float(((unsigned)(unsigned short)qr[d0][j])<<16);}
      float v0=-INFINITY,v1=-INFINITY,v2=-INFINITY; int i0=0,i1=0,i2=0;
      for(int n=0;n<qb;++n){
        const float*kr=km+n*D+hi*8; float g=0.f;
        #pragma unroll
        for(int d0=0;d0<4;++d0){ const float4 a=*reinterpret_cast<const float4*>(kr+d0*16),c4=*reinterpret_cast<const float4*>(kr+d0*16+4);
          g+=qf[d0*8+0]*a.x;g+=qf[d0*8+1]*a.y;g+=qf[d0*8+2]*a.z;g+=qf[d0*8+3]*a.w;g+=qf[d0*8+4]*c4.x;g+=qf[d0*8+5]*c4.y;g+=qf[d0*8+6]*c4.z;g+=qf[d0*8+7]*c4.w;}
        { auto rr=__builtin_amdgcn_permlane32_swap(__float_as_uint(g),__float_as_uint(g),false,false); g=__uint_as_float(rr[0])+__uint_as_float(rr[1]); }
        if(g>v0){v2=v1;i2=i1;v1=v0;i1=i0;v0=g;i0=n;} else if(g>v1){v2=v1;i2=i1;v1=g;i1=n;} else if(g>v2){v2=g;i2=n;}
      }
      selmask=(1u<<i0)|(1u<<i1)|(1u<<i2);
    }
    selmask|=(1u<<qb); }
  float mhat=0.f,l_reg=0.f;f32x16 o[2];o[0]=f32x16{};o[1]=f32x16{};f32x16 negm=f32x16{};asm volatile("":"+v"(negm));
  const int qrel=wid*QBLK+r32;
  #define CMASK(P0,P1,t) do{int jb_=(t)-(NT-4); if(jb_>=0)cmask(P0,P1,jb_,qrel,hi);}while(0)
  bool resc=false;
  #define START(P0,P1) do{ const float rm=rowmax(P0,P1); resc=false; \
    { const float dl=rm; mhat=fadd_s(mhat,dl); \
      _Pragma("unroll") for(int r=0;r<16;++r){P0[r]=fsub_s(P0[r],dl);P1[r]=fsub_s(P1[r],dl);} \
      _Pragma("unroll") for(int r=0;r<16;++r)negm[r]=-mhat; asm volatile("":"+v"(negm)); } \
    _Pragma("unroll") for(int r=0;r<16;++r)P0[r]=__builtin_amdgcn_exp2f(P0[r]); }while(0)
  #define RESC() do{ if(resc){ asm volatile("s_waitcnt lgkmcnt(0)":::"memory"); \
      _Pragma("unroll") for(int d_=0;d_<2;++d_) _Pragma("unroll") for(int r=0;r<16;++r)o[d_][r]*=wsf[crow(r,hi)]; } }while(0)
  f32x16 pA0,pA1,pB0,pB1;
  int sl_prev=0,sl_cur=0,sl_next=SLOTB;
  #define ROT() do{sl_prev=sl_cur;sl_cur=sl_next;sl_next=(sl_next==(NSLOT-1)*SLOTB)?0:sl_next+SLOTB;}while(0)
  DMA_K(2,2*SLOTB);
  WAIT_BAR(3);
  qkt(pA0,pA1,Kbase,qr,negm,r32,hi);asm volatile("s_nop 15\n\ts_nop 7":"+v"(pA0),"+v"(pA1));CMASK(pA0,pA1,0);
  START(pA0,pA1);
  _Pragma("unroll") for(int r=0;r<16;++r)pA1[r]=__builtin_amdgcn_exp2f(pA1[r]);
  WAIT_BAR(0);
  DMA_K(3,0);DMA_V(1,SLOTB);
  ROT();
  kload8(kf,kp0+sl_cur);
  WAIT_BAR(2);
  s16x4 vlo[8],vhi[8]; u32x4 pw0,pw1,pw2,pw3;
  #define PKW(P,B) (cvtpk_s(P[B],P[B+1])&selw)
  #define PAF(k) __builtin_bit_cast(bf16x8,pw##k)
  #define VFR(i) (bf16x8){vlo[i][0],vlo[i][1],vlo[i][2],vlo[i][3],vhi[i][0],vhi[i][1],vhi[i][2],vhi[i][3]}
  #define PIN(x) asm volatile("":"+v"(x))
  #define MX3(a,b,c) __builtin_fmaxf(__builtin_fmaxf((a),(b)),(c))
  #define GAPA(MF,A0,A1,A2,A3,W0,W1,PW) do{ MF; sacc+=A0; sacc+=A1; sacc+=A2; sacc+=A3; PIN(sacc); W0; W1; PIN(PW); SBAR(); }while(0)
  #define EX(v) __builtin_amdgcn_exp2f(v)
  #define GAPB(MF,X,B) do{ MF; X[B]=EX(X[B]); X[B+1]=EX(X[B+1]); X[B+2]=EX(X[B+2]); X[B+3]=EX(X[B+3]); PIN(X); SBAR(); }while(0)
  #define VRD(i) do{ vlo[i]=vtr(vp_+(((i)>>2)*4096+((i)&3)*1024)); vhi[i]=vtr(vp_+(((i)>>2)*4096+((i)&3)*1024+512)); }while(0)
  #define KRD(G,j) do{ if(G){ kload2(kf,kp0+sl_next,j); SBAR(); } }while(0)
  #define STEP(C0,C1,P0,P1,t,GK,GV,GL) do{ SBAR(); \
    const unsigned selw=0u-((selmask>>(((t)-1)>>2))&1u); \
    const lds_cptr vp_=vp0+sl_prev; \
    VRD(0); SBAR(); float sacc=(P0[0]+P0[1]); \
    GAPA(C0=__builtin_amdgcn_mfma_f32_32x32x16_bf16(kf[0],qr[0],negm,0,0,0), P0[2],P0[3],P0[4],P0[5],     pw0[0]=PKW(P0,0), pw0[1]=PKW(P0,2), pw0); \
    VRD(4); SBAR(); GAPA(C1=__builtin_amdgcn_mfma_f32_32x32x16_bf16(kf[1],qr[0],negm,0,0,0), P0[6],P0[7],P0[8],P0[9],     pw0[2]=PKW(P0,4), pw0[3]=PKW(P0,6), pw0); \
    VRD(1); SBAR(); GAPA(C0=__builtin_amdgcn_mfma_f32_32x32x16_bf16(kf[2],qr[1],C0,0,0,0),   P0[10],P0[11],P0[12],P0[13], pw1[0]=PKW(P0,8), pw1[1]=PKW(P0,10), pw1); \
    VRD(5); SBAR(); GAPA(C1=__builtin_amdgcn_mfma_f32_32x32x16_bf16(kf[3],qr[1],C1,0,0,0),   P0[14],P0[15],P1[0],P1[1],   pw1[2]=PKW(P0,12),pw1[3]=PKW(P0,14), pw1); \
    VRD(2); SBAR(); GAPA(C0=__builtin_amdgcn_mfma_f32_32x32x16_bf16(kf[4],qr[2],C0,0,0,0),   P1[2],P1[3],P1[4],P1[5],     pw2[0]=PKW(P1,0), pw2[1]=PKW(P1,2), pw2); \
    VRD(6); SBAR(); GAPA(C1=__builtin_amdgcn_mfma_f32_32x32x16_bf16(kf[5],qr[2],C1,0,0,0),   P1[6],P1[7],P1[8],P1[9],     pw2[2]=PKW(P1,4), pw2[3]=PKW(P1,6), pw2); \
    VRD(3); SBAR(); GAPA(C0=__builtin_amdgcn_mfma_f32_32x32x16_bf16(kf[6],qr[3],C0,0,0,0),   P1[10],P1[11],P1[12],P1[13], pw3[0]=PKW(P1,8), pw3[1]=PKW(P1,10), pw3); \
    VRD(7); SBAR(); GAPA(C1=__builtin_amdgcn_mfma_f32_32x32x16_bf16(kf[7],qr[3],C1,0,0,0),   P1[14],P1[15],0.f,0.f,       pw3[2]=PKW(P1,12),pw3[3]=PKW(P1,14), pw3); \
    l_reg+=sacc*__uint_as_float(selw&0x3f800000u); \
    if(GK){DMA_K((t)+3,sl_cur);} if(GV){DMA_V((t)+1,sl_next);} \
    CMASK(C0,C1,t); \
    { float a=MX3(C0[0],C0[1],C1[0]),b=MX3(C0[2],C0[3],C1[1]); a=MX3(a,C1[2],C1[3]); \
      _Pragma("unroll") for(int r=4;r<16;r+=4){a=MX3(a,C0[r],C0[r+1]);b=MX3(b,C0[r+2],C0[r+3]);a=MX3(a,C1[r],C1[r+1]);b=MX3(b,C1[r+2],C1[r+3]);} \
      float rm=__builtin_fmaxf(a,b); { auto rr=__builtin_amdgcn_permlane32_swap(__float_as_uint(rm),__float_as_uint(rm),false,false); rm=__builtin_fmaxf(__uint_as_float(rr[0]),__uint_as_float(rr[1])); } \
      resc=false; \
      if(__builtin_expect(__any(rm>(float)THRL),0)){ const float dl=__builtin_fmaxf(rm,0.f); mhat+=dl; \
        _Pragma("unroll") for(int r=0;r<16;++r){C0[r]-=dl;C1[r]-=dl;} \
        _Pragma("unroll") for(int r=0;r<16;++r)negm[r]=-mhat; asm volatile("":"+v"(negm)); \
        const float f=__builtin_amdgcn_exp2f(-dl); l_reg*=f; if(hi==0)wsf[r32]=f; resc=true; } } \
    SBAR(); \
    GAPB(o[0]=__builtin_amdgcn_mfma_f32_32x32x16_bf16(PAF(0),VFR(0),o[0],0,0,0), C0,0); \
    GAPB(o[1]=__builtin_amdgcn_mfma_f32_32x32x16_bf16(PAF(0),VFR(4),o[1],0,0,0), C0,4); \
    KRD(GL,0); GAPB(o[0]=__builtin_amdgcn_mfma_f32_32x32x16_bf16(PAF(1),VFR(1),o[0],0,0,0), C0,8); \
    KRD(GL,1); GAPB(o[1]=__builtin_amdgcn_mfma_f32_32x32x16_bf16(PAF(1),VFR(5),o[1],0,0,0), C0,12); \
    KRD(GL,2); GAPB(o[0]=__builtin_amdgcn_mfma_f32_32x32x16_bf16(PAF(2),VFR(2),o[0],0,0,0), C1,0); \
    KRD(GL,3); GAPB(o[1]=__builtin_amdgcn_mfma_f32_32x32x16_bf16(PAF(2),VFR(6),o[1],0,0,0), C1,4); \
    GAPB(o[0]=__builtin_amdgcn_mfma_f32_32x32x16_bf16(PAF(3),VFR(3),o[0],0,0,0), C1,8); \
    GAPB(o[1]=__builtin_amdgcn_mfma_f32_32x32x16_bf16(PAF(3),VFR(7),o[1],0,0,0), C1,12); \
    }while(0)
  int t=1;
  #undef CMASK
  #define CMASK(P0,P1,t) do{}while(0)
  for(;t+5<NT;t+=2){
    STEP(pB0,pB1,pA0,pA1,t,true,true,true);     WAIT_BAR(2); RESC(); ROT();
    STEP(pA0,pA1,pB0,pB1,t+1,true,true,true);   WAIT_BAR(2); RESC(); ROT();
  }
  #undef CMASK
  #define CMASK(P0,P1,t) do{int jb_=(t)-(NT-4); if(jb_>=0)cmask(P0,P1,jb_,qrel,hi);}while(0)
  #define ENDW(tt) do{ if((tt)+3<NT){WAIT_BAR(2);} else if((tt)+2<NT){WAIT_BAR(1);} else {WAIT_BAR(0);} }while(0)
  for(;t+1<NT;t+=2){
    STEP(pB0,pB1,pA0,pA1,t,(t+3<NT),(t+1<NT),(t+1<NT));       ENDW(t);   RESC(); ROT();
    STEP(pA0,pA1,pB0,pB1,t+1,(t+4<NT),(t+2<NT),(t+2<NT));     ENDW(t+1); RESC(); ROT();
  }
  STEP(pB0,pB1,pA0,pA1,NT-1,false,false,false); RESC();
  { const unsigned selw=0xFFFFFFFFu; float sacc=pB0[0]+pB0[1]; _Pragma("unroll") for(int r=2;r<16;++r)sacc+=pB0[r]; _Pragma("unroll") for(int r=0;r<16;++r)sacc+=pB1[r]; l_reg+=sacc;
    pw0=(u32x4){PKW(pB0,0),PKW(pB0,2),PKW(pB0,4),PKW(pB0,6)};pw1=(u32x4){PKW(pB0,8),PKW(pB0,10),PKW(pB0,12),PKW(pB0,14)};pw2=(u32x4){PKW(pB1,0),PKW(pB1,2),PKW(pB1,4),PKW(pB1,6)};pw3=(u32x4){PKW(pB1,8),PKW(pB1,10),PKW(pB1,12),PKW(pB1,14)};
    SBAR(); pv(o,vb0+sl_cur,PAF(0),PAF(1),PAF(2),PAF(3)); }
  #undef PKW
  #undef PAF
  #undef VFR
  #undef PIN
  #undef MX3
  #undef GAPA
  #undef GAPB
  #undef EX
  #undef VRD
  #undef KRD
  #undef STEP
  #undef ENDW
  {auto rr=__builtin_amdgcn_permlane32_swap(__float_as_uint(l_reg),__float_as_uint(l_reg),false,false);l_reg=__uint_as_float(rr[0])+__uint_as_float(rr[1]);}
  if(hi==0)wsf[32+r32]=l_reg;asm volatile("s_waitcnt lgkmcnt(0)":::"memory");
  float rli[16];
  #pragma unroll
  for(int r=0;r<16;++r)rli[r]=__builtin_amdgcn_rcpf(wsf[32+crow(r,hi)]);
  bf16*Ow=O+(rowbase+q0+wid*QBLK)*DM+h*D;
  { bf16*stg=(bf16*)(shm+LDS_OST)+wid*2048;
    #pragma unroll
    for(int r=0;r<16;++r){const int orow=crow(r,hi);
      #pragma unroll
      for(int d0=0;d0<2;++d0)stg[orow*64+d0*32+r32]=__float2bfloat16(o[d0][r]*rli[r]);}
    asm volatile("s_waitcnt lgkmcnt(0)":::"memory");
    #pragma unroll
    for(int i=0;i<4;++i){const int row=i*8+(lane>>3),ch=lane&7; const u32x4 v=*(const u32x4*)(stg+row*64+ch*8); ATTN_STORE16(Ow+(long)row*DM+ch*8,v);} }
  asm volatile("s_waitcnt lgkmcnt(0)\n\ts_barrier":::"memory");
  #undef DMA_K
  #undef DMA_V
  #undef CMASK
  #undef START
  #undef RESC
  #undef ROT
}
constexpr int ATTN_LDS_BYTES=LDS_BYTES;
struct AttnTensors { const bf16* Q; const bf16* K; const bf16* V; bf16* O; const float* KM; };
struct AttnUnit { int bh; int qb; };
struct StaticOrder {
  int vcu;
  __device__ __forceinline__ explicit StaticOrder(int grid,int block):vcu((block%8)*(grid/8)+block/8){}
  __device__ __forceinline__ bool next(int i,AttnUnit&u)const{ if(i>=2)return false; const int s=vcu&7; u.bh=vcu>>3; u.qb=(i==0)?15-s:s; return true; }
  __device__ __forceinline__ void a_ready(const AttnUnit&)const{}
  __device__ __forceinline__ void done(const AttnUnit&)const{}
};
template<class Sched,int THRL=8> __device__ __forceinline__ void attn_phase(char*lds,const AttnTensors&T,const Sched&S,const int wid){
  AttnUnit u;
  for(int i=0;S.next(i,u);++i){ S.a_ready(u); attn_unit<THRL>(u.bh/NHEAD,u.bh%NHEAD,u.qb,T.Q,T.K,T.V,T.O,T.KM,lds,wid); S.done(u); }
}
#undef SBAR
#undef WAIT_BAR
}


constexpr int NWAVES = 8;
#ifndef MK_PER_PHASE
#define MK_PER_PHASE 1
#endif
constexpr int TT = 16384, DMODEL = 1024, SEQL = 4096, NBATCH = 4, NIN = 6656;
constexpr int NEXP = 64, TOPK = 6, DEXP = 256;
constexpr float LN_EPS = 1e-5f, GN_EPS = 1e-6f;
constexpr float ALPHA = 1.189207115002721f;
constexpr float QC2 = 0.125f * 1.4426950408889634f;
constexpr float RET_QS = 0.08838834764831845f;

constexpr size_t MiB = 1u << 20;
constexpr size_t WS_CTL = 0, CTL_ZERO_BYTES = 1 * MiB;
constexpr size_t WS_KMEAN = 512 * 1024;
constexpr size_t WS_COSA = 1 * MiB, WS_SINA = WS_COSA + 512 * 1024, WS_COSR = 2 * MiB, WS_SINR = 3 * MiB;
constexpr size_t WS_WIN = 4 * MiB, WS_WMU = 17 * MiB, WS_WRU = 18 * MiB, WS_WOUT = 20 * MiB, WS_WSGU = 22 * MiB, WS_WSD = 23 * MiB, WS_WPP = WS_WSD + 512 * 1024, WS_WPG = 24 * MiB,
                 WS_WRTH = 26 * MiB, WS_WRTL = WS_WRTH + 128 * 1024;
constexpr size_t WS_LIST = 27 * MiB, WS_TOPE = 31 * MiB, WS_TOPW = WS_TOPE + 384 * 1024, WS_PPOS = WS_TOPW + 384 * 1024;
constexpr size_t WS_ARENA = 33 * MiB;
constexpr size_t A_GR = WS_ARENA + 0 * MiB;
constexpr size_t A_KA = WS_ARENA + 32 * MiB, A_VA = WS_ARENA + 48 * MiB;
constexpr size_t A_WED = A_KA;
constexpr size_t A_QA = WS_ARENA + 64 * MiB;
constexpr size_t A_KR = WS_ARENA + 80 * MiB;
constexpr size_t A_KZT = WS_ARENA + 96 * MiB;
constexpr size_t A_AP = WS_ARENA + 112 * MiB;
constexpr size_t A_BP = WS_ARENA + 160 * MiB;
constexpr size_t A_GA = WS_ARENA + 208 * MiB, A_GB = WS_ARENA + 240 * MiB;
constexpr size_t A_Z1 = WS_ARENA + 112 * MiB;
constexpr size_t A_H1LO = WS_ARENA + 176 * MiB;
constexpr size_t A_PB = WS_ARENA + 256 * MiB;
constexpr size_t A_ACT = WS_ARENA + 64 * MiB;
constexpr size_t A_ACTS = WS_ARENA + 113 * MiB;
constexpr size_t A_Y2 = WS_ARENA + 128 * MiB;
constexpr size_t WS_END = WS_ARENA + 272 * MiB;
constexpr int Y1_ROWS = 32768;
static_assert(WS_END <= 331636992ull, "d_ws map exceeds the guaranteed workspace");
constexpr size_t DO_XB = 0, DO_KVT = 32 * MiB, DO_WEGU = 0;
constexpr int CW_TMO = 0, CW_BAR = 4096, CW_GCNT = 8192;

constexpr int RING_OFF = 0, RING_BYTES = 131072, EPI_OFF = 131072, EPI_BYTES = 16384, LDSCTL_OFF = EPI_OFF + EPI_BYTES, LDS_BYTES = LDSCTL_OFF + 4096;

typedef GAS unsigned gu32;
#define RLX_AGENT __ATOMIC_RELAXED, __HIP_MEMORY_SCOPE_AGENT
#define LDS_WAIT() asm volatile("s_waitcnt lgkmcnt(0)" ::: "memory")
#define VM_WAIT() asm volatile("s_waitcnt vmcnt(0)" ::: "memory")
#define WG_BAR() do { asm volatile("s_waitcnt lgkmcnt(0)" ::: "memory"); __builtin_amdgcn_s_barrier(); asm volatile("" ::: "memory"); } while (0)

#define XB_TMO      128
#define XB_XCNT(j)  (256  + 64 * (j))
#define XB_XSUB(j)  (1280 + 64 * (j))
#define XB_XGEN(j)  (2304 + 64 * (j))
#define XB_TOP      3328
#define XB_TOPGEN   3392
#define XCD_BAR_WORDS 3456
#define XB_SPIN_CAP (1u << 18)

__device__ __forceinline__ unsigned xb_ld(unsigned* p)              { return __hip_atomic_load(p, __ATOMIC_RELAXED, __HIP_MEMORY_SCOPE_AGENT); }
__device__ __forceinline__ unsigned xb_add(unsigned* p, unsigned v) { return __hip_atomic_fetch_add(p, v, __ATOMIC_RELAXED, __HIP_MEMORY_SCOPE_AGENT); }
__device__ __forceinline__ unsigned xb_xcc_id() { return (unsigned)__builtin_amdgcn_s_getreg((3 << 11) | 20) & 0xFu; }
#define XB_SPIN(cond, bar) do { unsigned _sp = 0; while (cond) { __builtin_amdgcn_s_sleep(1); \
    if ((++_sp & 255u) == 0u) { if (xb_ld(&(bar)[XB_TMO])) break; if (_sp > XB_SPIN_CAP) { atomicAdd(&(bar)[XB_TMO], 1u); break; } } } } while (0)

struct XcdBarrier {
    unsigned* bar; unsigned x; int w;
    volatile LAS unsigned* st;
};

__device__ __forceinline__ XcdBarrier xcd_barrier_post(unsigned* bar, volatile LAS unsigned* st, int wave) {
    XcdBarrier b; b.bar = bar; b.x = xb_xcc_id(); b.st = st; b.w = wave;
    if (wave == 0 && lane_id_v() == 0) (void)xb_add(&bar[XB_XCNT(b.x)], 1u);
    return b;
}
__device__ __forceinline__ void xcd_barrier_complete(unsigned* bar, unsigned x, unsigned& nloc, unsigned& nx) {
    const unsigned G = gridDim.x * gridDim.y * gridDim.z;
    unsigned sum, cnt, mine, sp = 0u;
    for (;;) {
        sum = 0u; cnt = 0u; mine = 0u;
#pragma unroll
        for (unsigned j = 0; j < 16; ++j) { const unsigned c = xb_ld(&bar[XB_XCNT(j)]); sum += c; cnt += (c > 0u) ? 1u : 0u; mine = (j == x) ? c : mine; }
        if (sum == G) break;
        __builtin_amdgcn_s_sleep(1);
        if ((++sp & 255u) == 0u) { if (xb_ld(&bar[XB_TMO])) break; if (sp > XB_SPIN_CAP) { atomicAdd(&bar[XB_TMO], 1u); break; } }
    }
    nloc = mine > 0u ? mine : 1u; nx = cnt > 0u ? cnt : 1u;
}

__device__ __forceinline__ void xcd_barrier(const XcdBarrier& b) {
    asm volatile("s_waitcnt vmcnt(0)" ::: "memory");
    __syncthreads();
    if (b.w == 0 && lane_id_v() == 0) {
        unsigned* bar = b.bar;
        __builtin_amdgcn_s_waitcnt(0);
        unsigned nloc = b.st[0], nx = b.st[1];
        if (nloc == 0u) { xcd_barrier_complete(bar, b.x, nloc, nx); b.st[0] = nloc; b.st[1] = nx; }
        const unsigned old = xb_add(&bar[XB_XSUB(b.x)], 1u);
        const unsigned gen = old / nloc;
        if (old + 1u == (gen + 1u) * nloc) {
            __builtin_amdgcn_fence(__ATOMIC_RELEASE, "agent");
            asm volatile("s_waitcnt vmcnt(0)" ::: "memory");
            const unsigned og = xb_add(&bar[XB_TOP], 1u);
            const unsigned tg = og / nx;
            if (og + 1u == (tg + 1u) * nx) xb_add(&bar[XB_TOPGEN], 1u);
            else XB_SPIN(xb_ld(&bar[XB_TOPGEN]) == tg, bar);
            __builtin_amdgcn_fence(__ATOMIC_ACQUIRE, "agent");
            xb_add(&bar[XB_XGEN(b.x)], 1u);
            asm volatile("s_waitcnt vmcnt(0)" ::: "memory");
        } else {
            XB_SPIN(xb_ld(&bar[XB_XGEN(b.x)]) == gen, bar);
            __builtin_amdgcn_fence(__ATOMIC_ACQUIRE, "agent");
            asm volatile("s_waitcnt vmcnt(0)" ::: "memory");
        }
    }
    __syncthreads();
}


struct Frame {
    LAS unsigned char* lds;
    volatile LAS unsigned* LC;
    unsigned* ctl;
    int wave, vcu, G;
    float* out; unsigned char* ws;
};
typedef const __attribute__((address_space(4))) char* karg_t;
__device__ __forceinline__ const float* inp(int i) { unsigned z; asm volatile("s_mov_b32 %0, 0" : "=s"(z)); karg_t k = (karg_t)__builtin_amdgcn_kernarg_segment_ptr(); return *(const float* const __attribute__((address_space(4)))*)(k + z + 8 * i); }
__device__ __forceinline__ float wave_sum(float v) {
#pragma unroll
    for (int o = 1; o < 64; o <<= 1) v += __shfl_xor(v, o);
    return v;
}
__device__ __forceinline__ float log2gamma(int h) { return h == 0 ? -0.04580368961312479f : (h == 1 ? -0.02272007650008353f : (h == 2 ? -0.011315313227834146f : -0.005646563141142063f)); }
__device__ __forceinline__ float ex2(float x) { return __builtin_amdgcn_exp2f(x); }

template <class CM>
__device__ __forceinline__ void transpose_item(const float* W, int ldw, int K, bf16_t* WT, bf16_t* WT2, int k0, int n0, const CM& cm, LAS float* scr, int lane) {
    const int sc = cm(n0 + (lane & 31));
#pragma unroll 8
    for (int i = 0; i < 32; ++i) { const int kk = 2 * i + (lane >> 5); scr[kk * 33 + (lane & 31)] = W[(size_t)(k0 + kk) * ldw + sc]; }
    LDS_WAIT(); asm volatile("" ::: "memory");
    const int c = lane & 7;
#pragma unroll
    for (int j = 0; j < 4; ++j) { const int n = (lane >> 3) + 8 * j; const LAS float* s = scr + (8 * c) * 33 + n;
        float v[8];
#pragma unroll
        for (int q = 0; q < 8; ++q) v[q] = s[q * 33];
        u32x4 o; o.x = pk2(v[0], v[1]); o.y = pk2(v[2], v[3]); o.z = pk2(v[4], v[5]); o.w = pk2(v[6], v[7]);
        *(u32x4*)(WT + (size_t)(n0 + n) * K + k0 + 8 * c) = o;
        if (WT2) { u32x4 p; p.x = pk2(v[0] - bflo(o.x), v[1] - bfhi(o.x)); p.y = pk2(v[2] - bflo(o.y), v[3] - bfhi(o.y)); p.z = pk2(v[4] - bflo(o.z), v[5] - bfhi(o.z)); p.w = pk2(v[6] - bflo(o.w), v[7] - bfhi(o.w));
            *(u32x4*)(WT2 + (size_t)(n0 + n) * K + k0 + 8 * c) = p; } }
    LDS_WAIT(); asm volatile("" ::: "memory");
}
struct CmId { __device__ __forceinline__ int operator()(int n) const { return n; } };
struct CmWin {
    __device__ __forceinline__ int operator()(int c) const {
        if (c < 1024) { const int r = c >> 9, cc = c & 511, hd = cc >> 6, g2 = (cc >> 5) & 1, n = (cc >> 4) & 1, p = cc & 15; return r * 512 + hd * 64 + 16 * g2 + p + 32 * n; }
        if (c >= 1536 && c < 2560) { const int q = c - 1536, r = q >> 9, cc = q & 511, hd = cc >> 7, w = (cc >> 5) & 3, n = (cc >> 4) & 1, p = cc & 15; return 1536 + r * 512 + hd * 128 + 16 * w + p + 64 * n; }
        return c; }
};
struct CmRouter { __device__ __forceinline__ int operator()(int rho) const { const int nt = rho >> 4, q = (rho >> 2) & 3, reg = rho & 3; return 16 * q + 4 * nt + reg; } };
struct CmOff { int off; __device__ __forceinline__ int operator()(int n) const { return n + off; } };

__device__ __forceinline__ void cvt_rows_bf16(const float* src, bf16_t* dst, size_t n8, int gtid, int gthreads) {
    for (size_t i = gtid; i < n8; i += gthreads) { const f32x4 a = *(const f32x4*)(src + i * 8), b = *(const f32x4*)(src + i * 8 + 4);
        u32x4 o; o.x = pk2(a[0], a[1]); o.y = pk2(a[2], a[3]); o.z = pk2(b[0], b[1]); o.w = pk2(b[2], b[3]); *(u32x4*)(dst + i * 8) = o; }
}

__device__ __forceinline__ void p0_prep(Frame& F) {
    const int lane_ = lane_id_v(), tid_ = F.wave * 64 + lane_;
    LAS float* scr = (LAS float*)(F.lds + RING_OFF + F.wave * 16384);
    const int gw = F.vcu * NWAVES + F.wave, NGW = F.G * NWAVES;
    unsigned char* ws = F.ws;
    constexpr int I_WIN = 16 * (NIN / 32), I_WMU = 8 * 32, I_WRU = 16 * 32, I_WOUT = 16 * 32, I_SGU = 16 * 16, I_SD = 4 * 32, I_PP = 4 * 32, I_PG = 16 * 32, I_RT = 16 * 2;
    constexpr int NITEMS = I_WIN + I_WMU + I_WRU + I_WOUT + I_SGU + I_SD + I_PP + I_PG + I_RT;
    for (int it = gw; it < NITEMS; it += NGW) {
        int r = it;
        if (r < I_WIN) { const int nb = r % (NIN / 32), kb = r / (NIN / 32); transpose_item(inp(2), NIN, 1024, (bf16_t*)(ws + WS_WIN), nullptr, kb * 64, nb * 32, CmWin{}, scr, lane_); continue; } r -= I_WIN;
        if (r < I_WMU) { const int nb = r % 32, kb = r / 32; transpose_item(inp(3), 1024, 512, (bf16_t*)(ws + WS_WMU), nullptr, kb * 64, nb * 32, CmId{}, scr, lane_); continue; } r -= I_WMU;
        if (r < I_WRU) { const int nb = r % 32, kb = r / 32; transpose_item(inp(4), 1024, 1024, (bf16_t*)(ws + WS_WRU), nullptr, kb * 64, nb * 32, CmId{}, scr, lane_); continue; } r -= I_WRU;
        if (r < I_WOUT) { const int nb = r % 32, kb = r / 32; transpose_item(inp(5), 1024, 1024, (bf16_t*)(ws + WS_WOUT), nullptr, kb * 64, nb * 32, CmId{}, scr, lane_); continue; } r -= I_WOUT;
        if (r < I_SGU) { const int nb = r % 16, kb = r / 16; const int n0 = nb * 32, pn = n0 >> 8, lr = n0 & 255;
            const float* src = (lr < 128) ? inp(13) : inp(14); const int off = 128 * pn + (lr & 127) - n0;
            transpose_item(src, 256, 1024, (bf16_t*)(ws + WS_WSGU), nullptr, kb * 64, n0, CmOff{off}, scr, lane_); continue; } r -= I_SGU;
        if (r < I_SD) { const int nb = r % 32, kb = r / 32; transpose_item(inp(15), 1024, 256, (bf16_t*)(ws + WS_WSD), nullptr, kb * 64, nb * 32, CmId{}, scr, lane_); continue; } r -= I_SD;
        if (r < I_PP) { const int nb = r % 32, kb = r / 32; transpose_item(inp(18), 1024, 256, (bf16_t*)(ws + WS_WPP), nullptr, kb * 64, nb * 32, CmId{}, scr, lane_); continue; } r -= I_PP;
        if (r < I_PG) { const int nb = r % 32, kb = r / 32; transpose_item(inp(19), 1024, 1024, (bf16_t*)(ws + WS_WPG), nullptr, kb * 64, nb * 32, CmId{}, scr, lane_); continue; } r -= I_PG;
        { const int nb = r % 2, kb = r / 2; transpose_item(inp(8), 64, 1024, (bf16_t*)(ws + WS_WRTH), (bf16_t*)(ws + WS_WRTL), kb * 64, nb * 32, CmRouter{}, scr, lane_); }
    }
    const int gtid = F.vcu * (NWAVES * 64) + tid_, gth = F.G * NWAVES * 64;
    cvt_rows_bf16(inp(0), (bf16_t*)((unsigned char*)F.out + DO_XB), (size_t)TT * DMODEL / 8, gtid, gth);
    for (int i = gtid; i < SEQL * 96; i += gth) {
        const int pos = i / 96, j = i % 96;
        float invf; float* cdst; float* sdst;
        if (j < 32) { invf = (float)(1.0 / pow(10000.0, (double)j / 32.0)); cdst = (float*)(ws + WS_COSA) + pos * 32 + j; sdst = (float*)(ws + WS_SINA) + pos * 32 + j; }
        else { const int jj = j - 32; invf = (float)(1.0 / pow(10000.0, (double)jj / 63.0)); cdst = (float*)(ws + WS_COSR) + pos * 64 + jj; sdst = (float*)(ws + WS_SINR) + pos * 64 + jj; }
        const float ang = (float)pos * invf;
        const double a = (double)ang, tw = 6.283185307179586476925287;
        const double rr = a - tw * rint(a / tw);
        float s, c; sincosf((float)rr, &s, &c);
        *cdst = c; *sdst = s;
    }
}

__device__ __forceinline__ void p6_convert(Frame& F) {
    const int lane_ = lane_id_v(), tid_ = F.wave * 64 + lane_;
    LAS float* scr = (LAS float*)(F.lds + RING_OFF + F.wave * 16384);
    const int gw = F.vcu * NWAVES + F.wave, NGW = F.G * NWAVES;
    constexpr int I_GU = 16 * 16, I_D = 4 * 32, PER_E = I_GU + I_D;
    bf16_t* wegu = (bf16_t*)((unsigned char*)F.out + DO_WEGU); bf16_t* wed = (bf16_t*)(F.ws + A_WED);
    for (int it = gw; it < NEXP * PER_E; it += NGW) {
        const int e = it / PER_E; int r = it % PER_E;
        if (r < I_GU) { const int nb = r % 16, kb = r / 16; const int n0 = nb * 32, pn = n0 >> 8, lr = n0 & 255;
            const float* src = ((lr < 128) ? inp(10) : inp(11)) + (size_t)e * 1024 * 256; const int off = 128 * pn + (lr & 127) - n0;
            transpose_item(src, 256, 1024, wegu + (size_t)e * 512 * 1024, nullptr, kb * 64, n0, CmOff{off}, scr, lane_); }
        else { r -= I_GU; const int nb = r % 32, kb = r / 32;
            transpose_item(inp(12) + (size_t)e * 256 * 1024, 1024, 256, wed + (size_t)e * 1024 * 256, nullptr, kb * 64, nb * 32, CmId{}, scr, lane_); }
    }
    const int gtid = F.vcu * (NWAVES * 64) + tid_, gth = F.G * NWAVES * 64;
    cvt_rows_bf16(inp(1), (bf16_t*)(F.ws + A_PB), (size_t)TT * 256 / 8, gtid, gth);
}

using pg8::Unit;
struct TileSched {
    const char* A; const char* B; int lda, ldb, nM, nN, G, c;
    __device__ __forceinline__ bool next(int i, Unit& u) const {
        const int nwg = nM * nN; const long L = (long)i * G + c; if (L >= nwg) return false;
        int wgid = (int)L; { const int q = nwg / 8, r = nwg % 8, xcd = wgid % 8, off = wgid / 8; wgid = (xcd < r ? xcd * (q + 1) : r * (q + 1) + (xcd - r) * q) + off; }
        const int nig = 8 * nN, gid = wgid / nig, fm = gid * 8, gsz = (nM - fm) < 8 ? (nM - fm) : 8;
        const int pm = fm + ((wgid % nig) % gsz), pn = (wgid % nig) / gsz;
        u.A = A + (size_t)pm * 256 * lda * 2; u.B = B + (size_t)pn * 256 * ldb * 2; u.i0 = pm; u.i1 = pn; u.i2 = 0; u.i3 = 0; return true;
    }
};
struct RetSchedA {
    const char* AP; const char* KR; int G, c;
    __device__ __forceinline__ bool next(int i, Unit& u) const { const int L = i * G + c; if (L >= 256) return false;
        const int bh = L >> 4, cc = L & 15, b = bh >> 2, h = bh & 3;
        u.A = AP + (size_t)L * 256 * 384 * 2 + 256 * 2; u.B = KR + ((size_t)(b * SEQL + cc * 256) * 512 + h * 128) * 2; u.i0 = L; u.i1 = h; u.i2 = 0; u.i3 = 0; return true; }
};
struct RetSchedKV {
    const char* BP; const char* KZT; int G, c;
    __device__ __forceinline__ bool next(int i, Unit& u) const { const int L = i * G + c; if (L >= 256) return false;
        u.A = BP + (size_t)L * 256 * 384 * 2; u.B = KZT + (size_t)L * 128 * 256 * 2; u.i0 = L; u.i1 = (L >> 4) & 3; u.i2 = 0; u.i3 = 0; return true; }
};
struct RetSchedB {
    const char* AP; const char* BP; int G, c;
    __device__ __forceinline__ bool next(int i, Unit& u) const { const int L = i * G + c; if (L >= 256) return false;
        u.A = AP + (size_t)L * 256 * 384 * 2; u.B = BP + (size_t)L * 256 * 384 * 2; u.i0 = L; u.i1 = (L >> 4) & 3; u.i2 = 0; u.i3 = 0; return true; }
};
__device__ __forceinline__ unsigned rfl(unsigned v) { return (unsigned)__builtin_amdgcn_readfirstlane((int)v); }
__device__ __forceinline__ const char* rfl_ptr(const char* p) { const unsigned long long v = (unsigned long long)p; const unsigned lo = rfl((unsigned)v), hi = rfl((unsigned)(v >> 32)); return (const char*)(((unsigned long long)hi << 32) | lo); }
template <int NP, bool GU>
struct ExpSched {
    volatile LAS unsigned* offs; volatile LAS unsigned* ust; const int* list; const char* A; const char* B; int G, c;
    __device__ __forceinline__ bool next(int i, Unit& u) const {
        const unsigned L = (unsigned)(i * G + c); const unsigned ntile = rfl(ust[64]); if (L >= ntile * NP) return false;
        const unsigned tg = L / NP, pn = L % NP;
        unsigned e = 0;
#pragma unroll
        for (int s = 32; s >= 1; s >>= 1) { if (rfl(ust[e + s]) <= tg) e += s; }
        const unsigned o0 = rfl(offs[e]), o1 = rfl(offs[e + 1]), tile = tg - rfl(ust[e]), cnt = o1 - o0, slot = o0 + 256 * tile, nv = (cnt - 256 * tile) < 256u ? (cnt - 256 * tile) : 256u;
        u.i0 = (int)slot; u.i1 = (int)nv; u.i2 = (int)pn; u.i3 = (int)(e * 16384 + 256 * tile);
        if (GU) { u.A = A; u.B = B + ((size_t)e * 512 + pn * 256) * 1024 * 2; }
        else { u.A = A + (size_t)slot * 256 * 2; u.B = B + ((size_t)e * 1024 + pn * 256) * 256 * 2; }
        return true;
    }
    __device__ __forceinline__ unsigned row_off(const Unit& u, int r) const {
        const int rr = r < u.i1 ? r : 0; const int pair = list[u.i3 + rr]; return (unsigned)(pair / TOPK) * 2048u; }
};

#define EPI_ARGS const f32x4 (&acc)[2][2][4][2], const Unit& u, int wr, int wc, int fr, int fq, LAS unsigned char* el, int wid, int lane
__device__ __forceinline__ u32x2 pk4(const f32x4 v) { u32x2 w; w.x = pk2(v[0], v[1]); w.y = pk2(v[2], v[3]); return w; }
__device__ __forceinline__ f32x4 up4(const u32x2 w) { return (f32x4){bflo(w.x), bfhi(w.x), bflo(w.y), bfhi(w.y)}; }

struct EpiInProj {
    unsigned char* ws;
    __device__ __forceinline__ void operator()(EPI_ARGS) const {
        const int pm = u.i0, pn = u.i1, rowt = pm * 256, b = pm >> 4, c = pm & 15;
        unsigned char* ws = this->ws; asm volatile("" : "+s"(ws));
        bf16_t* const QA = (bf16_t*)(ws + A_QA); bf16_t* const KA = (bf16_t*)(ws + A_KA); bf16_t* const VA = (bf16_t*)(ws + A_VA); bf16_t* const KR = (bf16_t*)(ws + A_KR);
        bf16_t* const AP = (bf16_t*)(ws + A_AP); bf16_t* const BP = (bf16_t*)(ws + A_BP); bf16_t* const KZT = (bf16_t*)(ws + A_KZT); float* const KM = (float*)(ws + WS_KMEAN);
        const float* const cosA = (const float*)(ws + WS_COSA); const float* const sinA = (const float*)(ws + WS_SINA); const float* const cosR = (const float*)(ws + WS_COSR); const float* const sinR = (const float*)(ws + WS_SINR);
        if (pn < 4) {
            const bool isk = pn >= 2; bf16_t* dst = (bf16_t*)(ws + (isk ? A_KA : A_QA)); const float sc = isk ? 1.0f : QC2;
            const int j0 = 16 * (wc & 1) + 4 * fq, colb = (pn & 1) * 256 + 32 * wc + 4 * fq;
            f32x4 ks[2][2];
#pragma unroll
            for (int bj = 0; bj < 2; ++bj) { ks[bj][0] = (f32x4){0.f, 0.f, 0.f, 0.f}; ks[bj][1] = (f32x4){0.f, 0.f, 0.f, 0.f}; }
#pragma unroll
            for (int ai = 0; ai < 2; ++ai)
#pragma unroll
                for (int m = 0; m < 4; ++m) { const int lrow = 128 * ai + 64 * wr + 16 * m + fr, pos = c * 256 + lrow;
                    const f32x4 cs = *(const f32x4*)(cosA + pos * 32 + j0), sn = *(const f32x4*)(sinA + pos * 32 + j0);
                    bf16_t* rp = dst + (size_t)(rowt + lrow) * 512 + colb;
#pragma unroll
                    for (int bj = 0; bj < 2; ++bj) { const f32x4 x1 = acc[ai][bj][m][0], x2 = acc[ai][bj][m][1];
                        const f32x4 o1 = (x1 * cs - x2 * sn) * sc, o2 = (x2 * cs + x1 * sn) * sc;
                        *(u32x2*)(rp + 128 * bj) = pk4(o1); *(u32x2*)(rp + 128 * bj + 16) = pk4(o2);
                        ks[bj][0] += o1; ks[bj][1] += o2; } }
            if (isk) {
#pragma unroll
                for (int bj = 0; bj < 2; ++bj)
#pragma unroll
                    for (int n = 0; n < 2; ++n)
#pragma unroll
                        for (int i = 0; i < 4; ++i) { float v = ks[bj][n][i]; v += __shfl_xor(v, 1); v += __shfl_xor(v, 2); v += __shfl_xor(v, 4); v += __shfl_xor(v, 8);
                            if (fr == 0) { const int head = (pn & 1) * 4 + 2 * bj + (wc >> 1), dcol = 32 * (wc & 1) + 16 * n + 4 * fq + i;
                                atomicAdd(KM + ((size_t)(b * 8 + head) * 16 + c) * 64 + dcol, v); } }
            }
        } else if (pn < 6) {
#pragma unroll
            for (int ai = 0; ai < 2; ++ai)
#pragma unroll
                for (int m = 0; m < 4; ++m) { const int lrow = 128 * ai + 64 * wr + 16 * m + fr; bf16_t* rp = VA + (size_t)(rowt + lrow) * 512 + (pn - 4) * 256 + 32 * wc + 4 * fq;
#pragma unroll
                    for (int bj = 0; bj < 2; ++bj)
#pragma unroll
                        for (int n = 0; n < 2; ++n) *(u32x2*)(rp + 128 * bj + 16 * n) = pk4(acc[ai][bj][m][n]); }
        } else if (pn < 10) {
            const bool isk = pn >= 8; const int j0 = 16 * wc + 4 * fq;
#pragma unroll
            for (int bj = 0; bj < 2; ++bj) { const int h = 2 * ((pn - 6) & 1) + bj; const float L = log2gamma(h); const int item = (b * 4 + h) * 16 + c;
#pragma unroll
                for (int ai = 0; ai < 2; ++ai)
#pragma unroll
                    for (int m = 0; m < 4; ++m) { const int lrow = 128 * ai + 64 * wr + 16 * m + fr, pos = c * 256 + lrow;
                        const f32x4 cs = *(const f32x4*)(cosR + pos * 64 + j0), sn = *(const f32x4*)(sinR + pos * 64 + j0);
                        const f32x4 x1 = acc[ai][bj][m][0], x2 = acc[ai][bj][m][1];
                        f32x4 o1 = x1 * cs - x2 * sn, o2 = x2 * cs + x1 * sn;
                        if (!isk) { const float f = RET_QS * ex2((float)(lrow + 1) * L); o1 = o1 * f; o2 = o2 * f;
                            bf16_t* rp = AP + ((size_t)item * 256 + lrow) * 384 + 256 + 32 * wc + 4 * fq;
                            *(u32x2*)rp = pk4(o1); *(u32x2*)(rp + 16) = pk4(o2); }
                        else { bf16_t* rp = KR + (size_t)(rowt + lrow) * 512 + (pn - 8) * 256 + 128 * bj + 32 * wc + 4 * fq;
                            *(u32x2*)rp = pk4(o1); *(u32x2*)(rp + 16) = pk4(o2);
                            const float z = ex2((float)(255 - lrow) * L); o1 = o1 * z; o2 = o2 * z;
                            bf16_t* tp = KZT + (size_t)item * 32768 + (size_t)(32 * wc + 4 * fq) * 256 + lrow;
#pragma unroll
                            for (int i = 0; i < 4; ++i) { tp[i * 256] = f2bf(o1[i]); tp[(16 + i) * 256] = f2bf(o2[i]); } } } }
        } else if (pn < 14) {
            const int h = pn - 10, item = (b * 4 + h) * 16 + c;
#pragma unroll
            for (int ai = 0; ai < 2; ++ai)
#pragma unroll
                for (int m = 0; m < 4; ++m) { const int lrow = 128 * ai + 64 * wr + 16 * m + fr;
#pragma unroll
                    for (int bj = 0; bj < 2; ++bj)
#pragma unroll
                        for (int n = 0; n < 2; ++n) { bf16_t* tp = BP + ((size_t)item * 256 + 128 * bj + 32 * wc + 16 * n + 4 * fq) * 384 + lrow; const f32x4 v = acc[ai][bj][m][n];
#pragma unroll
                            for (int i = 0; i < 4; ++i) tp[i * 384] = f2bf(v[i]); } }
        } else {
            const int t = (pn - 14) >> 2; bf16_t* dst = (bf16_t*)(ws + (t == 0 ? A_GR : (t == 1 ? A_GA : A_GB))); const int cb = ((pn - 14) & 3) * 256 + 32 * wc + 4 * fq;
#pragma unroll
            for (int ai = 0; ai < 2; ++ai)
#pragma unroll
                for (int m = 0; m < 4; ++m) { const int lrow = 128 * ai + 64 * wr + 16 * m + fr; bf16_t* rp = dst + (size_t)(rowt + lrow) * 1024 + cb;
#pragma unroll
                    for (int bj = 0; bj < 2; ++bj)
#pragma unroll
                        for (int n = 0; n < 2; ++n) { const f32x4 x = acc[ai][bj][m][n]; f32x4 o;
#pragma unroll
                            for (int i = 0; i < 4; ++i) { const float s = sigmoidf_(x[i]); o[i] = (t == 0) ? x[i] * s : s; }
                            *(u32x2*)(rp + 128 * bj + 16 * n) = pk4(o); } }
        }
    }
};

struct EpiRetA {
    bf16_t* AP;
    __device__ __forceinline__ void operator()(EPI_ARGS) const {
        const int item = u.i0; const float L = log2gamma(u.i1);
#pragma unroll
        for (int bj = 0; bj < 2; ++bj)
#pragma unroll
            for (int n = 0; n < 2; ++n) { const int m0 = 128 * bj + 32 * wc + 16 * n + 4 * fq; f32x4 fac;
#pragma unroll
                for (int i = 0; i < 4; ++i) fac[i] = ex2(-(float)(m0 + i + 1) * L);
                bf16_t* cp = AP + (size_t)item * (256 * 384) + m0;
#pragma unroll
                for (int ai = 0; ai < 2; ++ai)
#pragma unroll
                    for (int m = 0; m < 4; ++m) { const int nrow = 128 * ai + 64 * wr + 16 * m + fr; f32x4 v = acc[ai][bj][m][n] * fac;
#pragma unroll
                        for (int i = 0; i < 4; ++i) v[i] = (m0 + i > nrow) ? 0.f : v[i];
                        *(u32x2*)(cp + nrow * 384) = pk4(v); }
                asm volatile("" ::: "memory"); }
    }
};
struct EpiRetKV {
    float* KVT;
    __device__ __forceinline__ void operator()(EPI_ARGS) const {
        const int item = u.i0;
#pragma unroll
        for (int ai = 0; ai < 2; ++ai)
#pragma unroll
            for (int m = 0; m < 4; ++m) { const int e = 128 * ai + 64 * wr + 16 * m + fr; float* rp = KVT + ((size_t)item * 256 + e) * 128 + 32 * wc + 4 * fq;
#pragma unroll
                for (int n = 0; n < 2; ++n) *(f32x4*)(rp + 16 * n) = acc[ai][0][m][n]; }
    }
};
struct EpiRetB {
    bf16_t* GR;
    __device__ __forceinline__ void operator()(EPI_ARGS) const {
        const int item = u.i0, h = u.i1, bh = item >> 4, c = item & 15, b = bh >> 2, rowt = b * SEQL + c * 256;
        LAS f32x2* P = (LAS f32x2*)el;
#pragma unroll
        for (int ai = 0; ai < 2; ++ai)
#pragma unroll
            for (int m = 0; m < 4; ++m) { float s = 0.f;
#pragma unroll
                for (int bj = 0; bj < 2; ++bj)
#pragma unroll
                    for (int n = 0; n < 2; ++n) { const f32x4 x = acc[ai][bj][m][n]; s += (x[0] + x[1]) + (x[2] + x[3]); }
                s += __shfl_xor(s, 16); s += __shfl_xor(s, 32);
                const float mw = s * (1.0f / 64.0f); float q = 0.f;
#pragma unroll
                for (int bj = 0; bj < 2; ++bj)
#pragma unroll
                    for (int n = 0; n < 2; ++n) { const f32x4 d = acc[ai][bj][m][n] - mw; q += (d[0] * d[0] + d[1] * d[1]) + (d[2] * d[2] + d[3] * d[3]); }
                q += __shfl_xor(q, 16); q += __shfl_xor(q, 32);
                if (fq == 0) P[(ai * 128 + wr * 64 + m * 16 + fr) * 4 + wc] = (f32x2){mw, q}; }
        WG_BAR();
#pragma unroll
        for (int ai = 0; ai < 2; ++ai)
#pragma unroll
            for (int m = 0; m < 4; ++m) { const int lrow = ai * 128 + wr * 64 + m * 16 + fr;
                const f32x2 a = P[lrow * 4 + 0], bb = P[lrow * 4 + 1], cc = P[lrow * 4 + 2], dd = P[lrow * 4 + 3];
                const float mt = (a.x + bb.x + cc.x + dd.x) * 0.25f; const float da = a.x - mt, db = bb.x - mt, dc = cc.x - mt, de = dd.x - mt;
                const float m2 = (a.y + bb.y) + (cc.y + dd.y) + 64.0f * ((da * da + db * db) + (dc * dc + de * de));
                const float rstd = 1.0f / sqrtf(m2 * (1.0f / 256.0f) + GN_EPS);
                bf16_t* rp = GR + (size_t)(rowt + lrow) * 1024 + h * 256 + 32 * wc + 4 * fq;
#pragma unroll
                for (int bj = 0; bj < 2; ++bj)
#pragma unroll
                    for (int n = 0; n < 2; ++n) { const f32x4 g = up4(*(const u32x2*)(rp + 128 * bj + 16 * n)); const f32x4 o = (acc[ai][bj][m][n] - mt) * rstd * g;
                        *(u32x2*)(rp + 128 * bj + 16 * n) = pk4(o); } }
        WG_BAR();
    }
};
struct EpiMergeA { bf16_t* GA;
    __device__ __forceinline__ void operator()(EPI_ARGS) const {
#pragma unroll
        for (int ai = 0; ai < 2; ++ai)
#pragma unroll
            for (int m = 0; m < 4; ++m) { const int row = u.i0 * 256 + 128 * ai + 64 * wr + 16 * m + fr; bf16_t* rp = GA + (size_t)row * 1024 + u.i1 * 256 + 32 * wc + 4 * fq;
#pragma unroll
                for (int bj = 0; bj < 2; ++bj)
#pragma unroll
                    for (int n = 0; n < 2; ++n) { u32x2* p = (u32x2*)(rp + 128 * bj + 16 * n); *p = pk4(acc[ai][bj][m][n] * up4(*p)); } }
    }
};
struct EpiMergeB { bf16_t* GA; const bf16_t* GB;
    __device__ __forceinline__ void operator()(EPI_ARGS) const {
#pragma unroll
        for (int ai = 0; ai < 2; ++ai)
#pragma unroll
            for (int m = 0; m < 4; ++m) { const int row = u.i0 * 256 + 128 * ai + 64 * wr + 16 * m + fr; const size_t o = (size_t)row * 1024 + u.i1 * 256 + 32 * wc + 4 * fq;
#pragma unroll
                for (int bj = 0; bj < 2; ++bj)
#pragma unroll
                    for (int n = 0; n < 2; ++n) { u32x2* p = (u32x2*)(GA + o + 128 * bj + 16 * n); const f32x4 g = up4(*(const u32x2*)(GB + o + 128 * bj + 16 * n)); *p = pk4(up4(*p) + acc[ai][bj][m][n] * g); } }
    }
};
struct EpiOutProj { const float* X; float* Z;
    __device__ __forceinline__ void operator()(EPI_ARGS) const {
#pragma unroll
        for (int ai = 0; ai < 2; ++ai)
#pragma unroll
            for (int m = 0; m < 4; ++m) { const int row = u.i0 * 256 + 128 * ai + 64 * wr + 16 * m + fr; const size_t o = (size_t)row * 1024 + u.i1 * 256 + 32 * wc + 4 * fq;
#pragma unroll
                for (int bj = 0; bj < 2; ++bj)
#pragma unroll
                    for (int n = 0; n < 2; ++n) { const f32x4 x = *(const f32x4*)(X + o + 128 * bj + 16 * n); *(f32x4*)(Z + o + 128 * bj + 16 * n) = x * ALPHA + acc[ai][bj][m][n]; } }
    }
};
struct EpiGateUp { bf16_t* ACT; bool dense;
    __device__ __forceinline__ void operator()(EPI_ARGS) const {
        const int rbase = dense ? u.i0 * 256 : u.i0, nv = dense ? 256 : u.i1, pn = dense ? u.i1 : u.i2;
#pragma unroll
        for (int ai = 0; ai < 2; ++ai)
#pragma unroll
            for (int m = 0; m < 4; ++m) { const int lrow = 128 * ai + 64 * wr + 16 * m + fr; bf16_t* rp = ACT + (size_t)(rbase + lrow) * 256 + pn * 128 + 32 * wc + 4 * fq;
                if (lrow < nv) {
#pragma unroll
                    for (int n = 0; n < 2; ++n) { const f32x4 g = acc[ai][0][m][n], v = acc[ai][1][m][n]; f32x4 o;
#pragma unroll
                        for (int i = 0; i < 4; ++i) o[i] = g[i] * sigmoidf_(g[i]) * v[i];
                        *(u32x2*)(rp + 16 * n) = pk4(o); } } }
    }
};
struct EpiExpDown { bf16_t* Y1; bf16_t* Y2; const int* list; const float* topw;
    __device__ __forceinline__ void operator()(EPI_ARGS) const {
        const int slot = u.i0, nv = u.i1, pn = u.i2, lb = u.i3;
        const unsigned coff = (unsigned)(pn * 256 + 32 * wc + 4 * fq) * 2u;
#pragma unroll
        for (int ai = 0; ai < 2; ++ai)
#pragma unroll
            for (int m = 0; m < 4; ++m) { const int lrow = 128 * ai + 64 * wr + 16 * m + fr;
                if (lrow < nv) { const float w = topw[list[lb + lrow]]; const int row = slot + lrow;
                    char* rp = (row < Y1_ROWS ? (char*)Y1 : (char*)Y2 - (size_t)Y1_ROWS * 2048) + (size_t)row * 2048 + coff;
#pragma unroll
                    for (int bj = 0; bj < 2; ++bj)
#pragma unroll
                        for (int n = 0; n < 2; ++n) *(u32x2*)(rp + 256 * bj + 32 * n) = pk4(acc[ai][bj][m][n] * w); }
                asm volatile("" ::: "memory"); }
    }
};
struct EpiShDown { bf16_t* H;
    __device__ __forceinline__ void operator()(EPI_ARGS) const {
#pragma unroll
        for (int ai = 0; ai < 2; ++ai)
#pragma unroll
            for (int m = 0; m < 4; ++m) { const int row = u.i0 * 256 + 128 * ai + 64 * wr + 16 * m + fr; bf16_t* rp = H + (size_t)row * 1024 + u.i1 * 256 + 32 * wc + 4 * fq;
#pragma unroll
                for (int bj = 0; bj < 2; ++bj)
#pragma unroll
                    for (int n = 0; n < 2; ++n) { u32x2* p = (u32x2*)(rp + 128 * bj + 16 * n); *p = pk4(up4(*p) * ALPHA + acc[ai][bj][m][n]); } }
    }
};
struct EpiPleG { float* O;
    __device__ __forceinline__ void operator()(EPI_ARGS) const {
#pragma unroll
        for (int ai = 0; ai < 2; ++ai)
#pragma unroll
            for (int m = 0; m < 4; ++m) { const int row = u.i0 * 256 + 128 * ai + 64 * wr + 16 * m + fr; float* rp = O + (size_t)row * 1024 + u.i1 * 256 + 32 * wc + 4 * fq;
#pragma unroll
                for (int bj = 0; bj < 2; ++bj)
#pragma unroll
                    for (int n = 0; n < 2; ++n) { const f32x4 x = acc[ai][bj][m][n]; f32x4 o;
#pragma unroll
                        for (int i = 0; i < 4; ++i) o[i] = sigmoidf_(x[i]);
                        *(f32x4*)(rp + 128 * bj + 16 * n) = o; } }
    }
};
struct EpiPleP { float* O; const bf16_t* H2;
    __device__ __forceinline__ void operator()(EPI_ARGS) const {
#pragma unroll
        for (int ai = 0; ai < 2; ++ai)
#pragma unroll
            for (int m = 0; m < 4; ++m) { const int row = u.i0 * 256 + 128 * ai + 64 * wr + 16 * m + fr; const size_t o = (size_t)row * 1024 + u.i1 * 256 + 32 * wc + 4 * fq;
#pragma unroll
                for (int bj = 0; bj < 2; ++bj)
#pragma unroll
                    for (int n = 0; n < 2; ++n) { f32x4* p = (f32x4*)(O + o + 128 * bj + 16 * n); const f32x4 h = up4(*(const u32x2*)(H2 + o + 128 * bj + 16 * n)); *p = h * ALPHA + acc[ai][bj][m][n] * (*p); } }
    }
};

__device__ __forceinline__ void ln_row(f32x4 (&v)[4], const float* g, const float* bta, int lane) {
    float s = 0.f;
#pragma unroll
    for (int j = 0; j < 4; ++j) s += (v[j][0] + v[j][1]) + (v[j][2] + v[j][3]);
    const float mean = wave_sum(s) * (1.f / DMODEL); float s2 = 0.f;
#pragma unroll
    for (int j = 0; j < 4; ++j) { v[j] = v[j] - mean; s2 += (v[j][0] * v[j][0] + v[j][1] * v[j][1]) + (v[j][2] * v[j][2] + v[j][3] * v[j][3]); }
    const float rstd = 1.f / sqrtf(wave_sum(s2) * (1.f / DMODEL) + LN_EPS);
#pragma unroll
    for (int j = 0; j < 4; ++j) { const f32x4 gg = *(const f32x4*)(g + 4 * lane + 256 * j), bb = *(const f32x4*)(bta + 4 * lane + 256 * j); v[j] = v[j] * rstd * gg + bb; }
}
__device__ __forceinline__ void p7_ln1(Frame& F) {
    const int lane_ = lane_id_v(), tid_ = F.wave * 64 + lane_;
    const int gw = F.vcu * NWAVES + F.wave, NGW = F.G * NWAVES;
    const float* Z = (const float*)(F.ws + A_Z1); bf16_t* H = (bf16_t*)(F.ws + A_GR); bf16_t* HL = (bf16_t*)(F.ws + A_H1LO);
    for (int r = gw; r < TT; r += NGW) {
        f32x4 v[4];
#pragma unroll
        for (int j = 0; j < 4; ++j) v[j] = *(const f32x4*)(Z + (size_t)r * 1024 + 4 * lane_ + 256 * j);
        ln_row(v, inp(6), inp(7), lane_);
#pragma unroll
        for (int j = 0; j < 4; ++j) { const u32x2 w = pk4(v[j]); const f32x4 lo = v[j] - up4(w);
            *(u32x2*)(H + (size_t)r * 1024 + 4 * lane_ + 256 * j) = w; *(u32x2*)(HL + (size_t)r * 1024 + 4 * lane_ + 256 * j) = pk4(lo); }
    }
}
__device__ __forceinline__ void p13_ln3(Frame& F) {
    const int lane_ = lane_id_v(), tid_ = F.wave * 64 + lane_;
    const int gw = F.vcu * NWAVES + F.wave, NGW = F.G * NWAVES;
    for (int r = gw; r < TT; r += NGW) {
        f32x4 v[4];
#pragma unroll
        for (int j = 0; j < 4; ++j) v[j] = *(const f32x4*)(F.out + (size_t)r * 1024 + 4 * lane_ + 256 * j);
        ln_row(v, inp(20), inp(21), lane_);
#pragma unroll
        for (int j = 0; j < 4; ++j) *(f32x4*)(F.out + (size_t)r * 1024 + 4 * lane_ + 256 * j) = v[j];
    }
}
__device__ __forceinline__ void build_expert_tables(Frame& F) {
    const int lane_ = lane_id_v(), tid_ = F.wave * 64 + lane_;
    if (tid_ == 0) { unsigned o = 0, t = 0;
        for (int e = 0; e < NEXP; ++e) { const unsigned c = __hip_atomic_load(F.ctl + CW_GCNT + e, RLX_AGENT); F.LC[64 + e] = o; F.LC[192 + e] = t; o += c; t += (c + 255u) >> 8; }
        F.LC[64 + 64] = o; F.LC[192 + 64] = t; }
    WG_BAR();
}
__device__ __forceinline__ void p11_combine(Frame& F) {
    const int lane_ = lane_id_v(), tid_ = F.wave * 64 + lane_;
    const int gw = F.vcu * NWAVES + F.wave, NGW = F.G * NWAVES;
    bf16_t* H = (bf16_t*)(F.ws + A_GR); const bf16_t* Y1 = (const bf16_t*)F.out; const bf16_t* Y2 = (const bf16_t*)(F.ws + A_Y2);
    const int* tope = (const int*)(F.ws + WS_TOPE); const int* ppos = (const int*)(F.ws + WS_PPOS);
    for (int r = gw; r < TT; r += NGW) {
        f32x4 v[4];
#pragma unroll
        for (int j = 0; j < 4; ++j) v[j] = up4(*(const u32x2*)(H + (size_t)r * 1024 + 4 * lane_ + 256 * j));
#pragma unroll
        for (int k = 0; k < TOPK; ++k) { const int e = tope[r * TOPK + k], row = (int)F.LC[64 + e] + ppos[r * TOPK + k];
            const bf16_t* yp = (row < Y1_ROWS ? Y1 + (size_t)row * 1024 : Y2 + (size_t)(row - Y1_ROWS) * 1024) + 4 * lane_;
#pragma unroll
            for (int j = 0; j < 4; ++j) v[j] += up4(*(const u32x2*)(yp + 256 * j)); }
        ln_row(v, inp(16), inp(17), lane_);
#pragma unroll
        for (int j = 0; j < 4; ++j) *(u32x2*)(H + (size_t)r * 1024 + 4 * lane_ + 256 * j) = pk4(v[j]);
    }
}
__device__ __forceinline__ void p3_prefix(Frame& F) {
    const int lane_ = lane_id_v(), tid_ = F.wave * 64 + lane_;
    const int idx = F.vcu * (NWAVES * 64) + tid_;
    if (idx >= 16 * 256 * 32) return;
    const int bh = idx >> 13, rem = idx & 8191, e = rem >> 5, d4 = (rem & 31) * 4, h = bh & 3;
    const float gC = ex2(256.0f * log2gamma(h));
    const float* KVT = (const float*)((const unsigned char*)F.out + DO_KVT); bf16_t* BP = (bf16_t*)(F.ws + A_BP);
    f32x4 kv[16];
#pragma unroll
    for (int c = 0; c < 16; ++c) kv[c] = *(const f32x4*)(KVT + ((size_t)(bh * 16 + c) * 256 + e) * 128 + d4);
    f32x4 st = (f32x4){0.f, 0.f, 0.f, 0.f};
#pragma unroll
    for (int c = 0; c < 16; ++c) { *(u32x2*)(BP + ((size_t)(bh * 16 + c) * 256 + e) * 384 + 256 + d4) = pk4(st); st = st * gC + kv[c]; }
}

__device__ __forceinline__ void p8_router(Frame& F) {
    const int lane_ = lane_id_v(), tid_ = F.wave * 64 + lane_;
    const bf16_t* H = (const bf16_t*)(F.ws + A_GR); const bf16_t* HL = (const bf16_t*)(F.ws + A_H1LO);
    const bf16_t* WH = (const bf16_t*)(F.ws + WS_WRTH); const bf16_t* WL = (const bf16_t*)(F.ws + WS_WRTL);
    int* tope = (int*)(F.ws + WS_TOPE); float* topw = (float*)(F.ws + WS_TOPW); int* ppos = (int*)(F.ws + WS_PPOS); int* list = (int*)(F.ws + WS_LIST);
    const float* rbias = inp(9);
    volatile LAS unsigned* hist = F.LC + 320; volatile LAS unsigned* gbase = F.LC + 384;
    const int lane = lane_, fr = lane & 15, fq = lane >> 4;
    for (int task = F.vcu; task < TT / 128; task += F.G) {
        if (tid_ < 64) hist[tid_] = 0u;
        WG_BAR();
        const int row = task * 128 + F.wave * 16 + fr;
        f32x4 acc[4];
#pragma unroll
        for (int nt = 0; nt < 4; ++nt) acc[nt] = (f32x4){0.f, 0.f, 0.f, 0.f};
        const bf16_t* ah = H + (size_t)row * 1024 + fq * 8; const bf16_t* al = HL + (size_t)row * 1024 + fq * 8;
        const bf16_t* bh = WH + (size_t)fr * 1024 + fq * 8; const bf16_t* bl = WL + (size_t)fr * 1024 + fq * 8;
#pragma unroll 2
        for (int k0 = 0; k0 < 1024; k0 += 32) {
            const bf16x8 a_h = *(const bf16x8*)(ah + k0), a_l = *(const bf16x8*)(al + k0);
#pragma unroll
            for (int nt = 0; nt < 4; ++nt) { const bf16x8 b_h = *(const bf16x8*)(bh + nt * 16 * 1024 + k0), b_l = *(const bf16x8*)(bl + nt * 16 * 1024 + k0);
                acc[nt] = __builtin_amdgcn_mfma_f32_16x16x32_bf16(b_h, a_h, acc[nt], 0, 0, 0);
                acc[nt] = __builtin_amdgcn_mfma_f32_16x16x32_bf16(b_h, a_l, acc[nt], 0, 0, 0);
                acc[nt] = __builtin_amdgcn_mfma_f32_16x16x32_bf16(b_l, a_h, acc[nt], 0, 0, 0); }
        }
        float sc[16], bi[16];
#pragma unroll
        for (int nt = 0; nt < 4; ++nt)
#pragma unroll
            for (int rg = 0; rg < 4; ++rg) { const int li = 4 * nt + rg; sc[li] = sigmoidf_(acc[nt][rg]); bi[li] = sc[li] + rbias[16 * fq + li]; }
        float gs[2];
#pragma unroll
        for (int g = 0; g < 2; ++g) { float m1 = -INFINITY, m2 = -INFINITY;
#pragma unroll
            for (int q = 0; q < 8; ++q) { const float v = bi[8 * g + q]; if (v > m1) { m2 = m1; m1 = v; } else if (v > m2) m2 = v; }
            gs[g] = m1 + m2; }
        float ga[8];
#pragma unroll
        for (int q = 0; q < 4; ++q) { ga[2 * q] = __shfl(gs[0], fr + 16 * q); ga[2 * q + 1] = __shfl(gs[1], fr + 16 * q); }
        bool sel[2];
#pragma unroll
        for (int g = 0; g < 2; ++g) { const int gi = 2 * fq + g; const float mine = gs[g]; int rank = 0;
#pragma unroll
            for (int q = 0; q < 8; ++q) rank += (ga[q] > mine || (ga[q] == mine && q < gi)) ? 1 : 0;
            sel[g] = rank < 4; }
        float cand[16];
#pragma unroll
        for (int li = 0; li < 16; ++li) cand[li] = sel[li >> 3] ? bi[li] : -INFINITY;
        int te[TOPK]; float tsv[TOPK]; float ssum = 0.f;
#pragma unroll
        for (int k = 0; k < TOPK; ++k) {
            float bv = cand[0]; int bidx = 0;
#pragma unroll
            for (int li = 1; li < 16; ++li) if (cand[li] > bv) { bv = cand[li]; bidx = li; }
            int be = 16 * fq + bidx;
#pragma unroll
            for (int o = 16; o <= 32; o <<= 1) { const float ov = __shfl_xor(bv, o); const int oe = __shfl_xor(be, o); if (ov > bv || (ov == bv && oe < be)) { bv = ov; be = oe; } }
            const bool own = (be >> 4) == fq; float s_own = 0.f;
#pragma unroll
            for (int li = 0; li < 16; ++li) { const bool hit = own && ((be & 15) == li); if (hit) { cand[li] = -INFINITY; s_own = sc[li]; } }
            const float s_w = __shfl(s_own, fr + 16 * (be >> 4));
            te[k] = be; tsv[k] = s_w; ssum += s_w;
        }
        unsigned lpos[TOPK];
        if (fq == 0) {
#pragma unroll
            for (int k = 0; k < TOPK; ++k) { tope[row * TOPK + k] = te[k]; topw[row * TOPK + k] = tsv[k] / ssum * 2.5f;
                lpos[k] = __hip_atomic_fetch_add((LAS unsigned*)(hist + te[k]), 1u, __ATOMIC_RELAXED, __HIP_MEMORY_SCOPE_WORKGROUP); }
        }
        WG_BAR();
        if (tid_ < 64) gbase[tid_] = __hip_atomic_fetch_add(F.ctl + CW_GCNT + tid_, hist[tid_], RLX_AGENT);
        WG_BAR();
        if (fq == 0) {
#pragma unroll
            for (int k = 0; k < TOPK; ++k) { const int pos = (int)(gbase[te[k]] + lpos[k]); list[te[k] * 16384 + pos] = row * TOPK + k; ppos[row * TOPK + k] = pos; }
        }
        WG_BAR();
    }
}

constexpr int N_PHASES = 14;
struct Args { const float* in[22]; float* out; unsigned char* ws; int ph_lo, ph_hi; };
__global__ void __launch_bounds__(NWAVES * 64, 2) moba_ret_moe_fwd(Args args) {
    extern __shared__ __attribute__((aligned(16))) unsigned char lds[];
    Frame F;
    F.lds = (LAS unsigned char*)lds;
    F.LC = (volatile LAS unsigned*)(F.lds + LDSCTL_OFF);
    F.wave = __builtin_amdgcn_readfirstlane((int)(threadIdx.x >> 6));
    F.G = gridDim.x; { const int bx = blockIdx.x; F.vcu = (F.G % 8 == 0) ? (bx % 8) * (F.G / 8) + bx / 8 : bx; }
    F.ws = args.ws; F.out = args.out; F.ctl = (unsigned*)(args.ws + WS_CTL);
    for (int w = threadIdx.x; w < (LDS_BYTES - LDSCTL_OFF) / 4; w += NWAVES * 64) ((LAS unsigned*)(F.lds + LDSCTL_OFF))[w] = 0u;
    __syncthreads();
    XcdBarrier bar; bar.bar = F.ctl + CW_BAR; bar.x = 0; bar.st = nullptr; bar.w = F.wave;
    if (!MK_PER_PHASE) bar = xcd_barrier_post(F.ctl + CW_BAR, F.LC + 0, F.wave);
    const int lo = args.ph_lo, hi = args.ph_hi;
#ifndef PH_MASK
#define PH_MASK 0xFFFF
#endif
#define IN(k) (((PH_MASK >> (k)) & 1) && lo <= (k) && (k) < hi)
#define SEAM(k) do { if (IN(k) && IN((k) + 1)) xcd_barrier(bar); } while (0)
    unsigned char* ws = F.ws; unsigned char* dob = (unsigned char*)F.out;
    LAS unsigned char* ring = F.lds + RING_OFF; LAS unsigned char* epi = F.lds + EPI_OFF;
    const int G = F.G, cb = (int)blockIdx.x;

    if (IN(0)) { p0_prep(F); }
    SEAM(0);
    if (IN(1)) {
        TileSched S{(const char*)(dob + DO_XB), (const char*)(ws + WS_WIN), 1024, 1024, 64, NIN / 256, G, cb};
        EpiInProj E{ws};
        pg8::gemm_phase<EpiInProj, TileSched, false>(F.wave, ring, epi, 1024, 1024, 1024, S, E);
    }
    SEAM(1);
    if (IN(2)) {
        { RetSchedA S{(const char*)(ws + A_AP), (const char*)(ws + A_KR), G, cb}; EpiRetA E{(bf16_t*)(ws + A_AP)};
          pg8::gemm_phase<EpiRetA, RetSchedA, false>(F.wave, ring, epi, 384, 512, 128, S, E); }
        { RetSchedKV S{(const char*)(ws + A_BP), (const char*)(ws + A_KZT), G, cb}; EpiRetKV E{(float*)(dob + DO_KVT)};
          pg8::gemm_phase<EpiRetKV, RetSchedKV, false>(F.wave, ring, epi, 384, 256, 256, S, E); }
    }
    SEAM(2);
    if (IN(3)) {
        p3_prefix(F);
        const attn_body::AttnTensors AT{(const attn_body::bf16*)(ws + A_QA), (const attn_body::bf16*)(ws + A_KA), (const attn_body::bf16*)(ws + A_VA), (attn_body::bf16*)(ws + A_QA), (const float*)(ws + WS_KMEAN)};
        const attn_body::StaticOrder S(G, cb);
        attn_body::attn_phase<attn_body::StaticOrder>((char*)lds + RING_OFF, AT, S, F.wave);
    }
    SEAM(3);
    if (IN(4)) {
        RetSchedB S{(const char*)(ws + A_AP), (const char*)(ws + A_BP), G, cb}; EpiRetB E{(bf16_t*)(ws + A_GR)};
        pg8::gemm_phase<EpiRetB, RetSchedB, false>(F.wave, ring, epi, 384, 384, 384, S, E);
    }
    SEAM(4);
    if (IN(5)) {
        { TileSched S{(const char*)(ws + A_QA), (const char*)(ws + WS_WMU), 512, 512, 64, 4, G, cb}; EpiMergeA E{(bf16_t*)(ws + A_GA)};
          pg8::gemm_phase<EpiMergeA, TileSched, false>(F.wave, ring, epi, 512, 512, 512, S, E); }
        { TileSched S{(const char*)(ws + A_GR), (const char*)(ws + WS_WRU), 1024, 1024, 64, 4, G, cb}; EpiMergeB E{(bf16_t*)(ws + A_GA), (const bf16_t*)(ws + A_GB)};
          pg8::gemm_phase<EpiMergeB, TileSched, false>(F.wave, ring, epi, 1024, 1024, 1024, S, E); }
    }
    SEAM(5);
    if (IN(6)) {
        { TileSched S{(const char*)(ws + A_GA), (const char*)(ws + WS_WOUT), 1024, 1024, 64, 4, G, cb}; EpiOutProj E{inp(0), (float*)(ws + A_Z1)};
          pg8::gemm_phase<EpiOutProj, TileSched, false>(F.wave, ring, epi, 1024, 1024, 1024, S, E); }
        p6_convert(F);
    }
    SEAM(6);
    if (IN(7)) { p7_ln1(F); }
    SEAM(7);
    if (IN(8)) { p8_router(F); }
    SEAM(8);
    if (IN(9)) {
        build_expert_tables(F);
        { ExpSched<2, true> S{F.LC + 64, F.LC + 192, (const int*)(ws + WS_LIST), (const char*)(ws + A_GR), (const char*)(dob + DO_WEGU), G, cb}; EpiGateUp E{(bf16_t*)(ws + A_ACT), false};
          pg8::gemm_phase<EpiGateUp, ExpSched<2, true>, true>(F.wave, ring, epi, 1024, 1024, 1024, S, E); }
        { TileSched S{(const char*)(ws + A_GR), (const char*)(ws + WS_WSGU), 1024, 1024, 64, 2, G, cb}; EpiGateUp E{(bf16_t*)(ws + A_ACTS), true};
          pg8::gemm_phase<EpiGateUp, TileSched, false>(F.wave, ring, epi, 1024, 1024, 1024, S, E); }
    }
    SEAM(9);
    if (IN(10)) {
        build_expert_tables(F);
        { ExpSched<4, false> S{F.LC + 64, F.LC + 192, (const int*)(ws + WS_LIST), (const char*)(ws + A_ACT), (const char*)(ws + A_WED), G, cb};
          EpiExpDown E{(bf16_t*)dob, (bf16_t*)(ws + A_Y2), (const int*)(ws + WS_LIST), (const float*)(ws + WS_TOPW)};
          pg8::gemm_phase<EpiExpDown, ExpSched<4, false>, false>(F.wave, ring, epi, 256, 256, 256, S, E); }
        { TileSched S{(const char*)(ws + A_ACTS), (const char*)(ws + WS_WSD), 256, 256, 64, 4, G, cb}; EpiShDown E{(bf16_t*)(ws + A_GR)};
          pg8::gemm_phase<EpiShDown, TileSched, false>(F.wave, ring, epi, 256, 256, 256, S, E); }
    }
    SEAM(10);
    if (IN(11)) { build_expert_tables(F); p11_combine(F); }
    SEAM(11);
    if (IN(12)) {
        { TileSched S{(const char*)(ws + A_GR), (const char*)(ws + WS_WPG), 1024, 1024, 64, 4, G, cb}; EpiPleG E{F.out};
          pg8::gemm_phase<EpiPleG, TileSched, false>(F.wave, ring, epi, 1024, 1024, 1024, S, E); }
        { TileSched S{(const char*)(ws + A_PB), (const char*)(ws + WS_WPP), 256, 256, 64, 4, G, cb}; EpiPleP E{F.out, (const bf16_t*)(ws + A_GR)};
          pg8::gemm_phase<EpiPleP, TileSched, false>(F.wave, ring, epi, 256, 256, 256, S, E); }
    }
    SEAM(12);
    if (IN(13)) { p13_ln3(F); }
#undef IN
#undef SEAM
}

extern "C" void kernel_launch(void* const* d_in, const int* in_sizes, int n_in, void* d_out, int out_size, void* d_ws, size_t ws_size, hipStream_t stream) {
    static int grid = 0;
    if (grid == 0) {
        if (n_in != 22 || out_size != TT * DMODEL || ws_size < WS_END) { fprintf(stderr, "kernel_launch: unexpected shapes (n_in %d out %d ws %zu)\n", n_in, out_size, ws_size); grid = -1; return; }
        int dev = 0, cus = 0, per_cu = 0;
        if (hipGetDevice(&dev) != hipSuccess || hipDeviceGetAttribute(&cus, hipDeviceAttributeMultiprocessorCount, dev) != hipSuccess) { grid = -1; return; }
        if (hipFuncSetAttribute((const void*)moba_ret_moe_fwd, hipFuncAttributeMaxDynamicSharedMemorySize, LDS_BYTES) != hipSuccess) { fprintf(stderr, "kernel_launch: hipFuncSetAttribute failed\n"); grid = -1; return; }
        if (hipOccupancyMaxActiveBlocksPerMultiprocessor(&per_cu, (const void*)moba_ret_moe_fwd, NWAVES * 64, LDS_BYTES) != hipSuccess || per_cu < 1)
            fprintf(stderr, "kernel_launch: note: occupancy query reports %d workgroups per CU\n", per_cu);
        (void)hipGetLastError();
        grid = cus;
    }
    if (grid < 0) return;
    if (hipMemsetAsync((char*)d_ws + WS_CTL, 0, CTL_ZERO_BYTES, stream) != hipSuccess) { fprintf(stderr, "kernel_launch: memset failed\n"); return; }
    Args a{};
    for (int i = 0; i < 22; ++i) a.in[i] = (const float*)d_in[i];
    a.out = (float*)d_out; a.ws = (unsigned char*)d_ws;
#if MK_PER_PHASE
    for (int p = 0; p < N_PHASES; ++p) { a.ph_lo = p; a.ph_hi = p + 1; hipLaunchKernelGGL(moba_ret_moe_fwd, dim3(grid), dim3(NWAVES * 64), LDS_BYTES, stream, a); }
#else
    a.ph_lo = 0; a.ph_hi = N_PHASES;
    hipLaunchKernelGGL(moba_ret_moe_fwd, dim3(grid), dim3(NWAVES * 64), LDS_BYTES, stream, a);
#endif
    const hipError_t le = hipPeekAtLastError();
    if (le != hipSuccess) fprintf(stderr, "kernel_launch: launch failed: %s\n", hipGetErrorName(le));
}
```
